# Optimizing an MI355X kernel written in HIP

```python
import math
import jax, jax.numpy as jnp
from jax import lax
import numpy as np

D_MODEL = 2048
BATCH = 32
SEQ = 256
DEPTH = 2
DEC_BATCH = 8
DEC_SEQ = 4096
PAST_LEN = 512

GRID_W = 64
MIX_W = D_MODEL // 4
HEAD_DIM = 64
D_FF = 4 * D_MODEL
NORM_EPS = 1e-6

GLA_H = MIX_W // HEAD_DIM
GLA_DK = HEAD_DIM // 2
GLA_DV = HEAD_DIM
GLA_RANK = 16
GLA_TAU = 16.0
GLA_CHUNK = 64

DIFF_H = MIX_W // HEAD_DIM
DIFF_DK = HEAD_DIM // 2
DIFF_DV = HEAD_DIM
Q_BLOCK = 128
ROPE_BASE = 10000.0

SSD_H = MIX_W // HEAD_DIM
SSD_P = HEAD_DIM
SSD_N = 64
SSD_G = 2
SSD_CONV = 3
SSD_CHUNK = 128

HY_CH = MIX_W
HY_SHORT = 3
HY_BANDS = 16
HY_EMB = 2 * HY_BANDS + 1
HY_HID = 64

GLA_QK = GLA_H * GLA_DK
GLA_V = GLA_H * GLA_DV
DIFF_QK = DIFF_H * 2 * DIFF_DK
DIFF_V = DIFF_H * DIFF_DV
SSD_DI = SSD_H * SSD_P
SSD_BC = SSD_G * SSD_N
SSD_XBC = SSD_DI + 2 * SSD_BC
HY_W = 3 * HY_CH
IN_SIZES = (GLA_QK, GLA_QK, GLA_V, GLA_V, 2 * GLA_RANK,
            DIFF_QK, DIFF_QK, DIFF_V,
            SSD_DI, SSD_XBC, 2 * SSD_H,
            HY_W)
IN_W = sum(IN_SIZES)

kernel_name = 'hybrid_prefix_diffusion_step'

f32 = jnp.float32


def rms_norm(x, g):
    xf = x.astype(f32)
    y = xf * lax.rsqrt(jnp.mean(xf * xf, axis=-1, keepdims=True) + NORM_EPS)
    return (y * g.astype(f32)).astype(x.dtype)


def split_cols(t, sizes):
    offs = np.cumsum(sizes)[:-1].tolist()
    return jnp.split(t, offs, axis=-1)


def flip(t):
    return jnp.flip(t, axis=1)


def dwconv_centred(x, w, b):
    K = w.shape[0]
    L = x.shape[1]
    xp = jnp.pad(x, ((0, 0), (K // 2, K // 2), (0, 0)))
    return sum(xp[:, i:i + L] * w[i] for i in range(K)) + b


def adaln(cvec, w, b):
    m = jax.nn.silu(cvec) @ w + b
    return jnp.split(m[:, None, :], 6, axis=-1)


def axial_rope(L):
    rows = L // GRID_W
    r, col = jnp.meshgrid(jnp.arange(rows), jnp.arange(GRID_W), indexing='ij')
    r = r.reshape(-1).astype(f32)
    col = col.reshape(-1).astype(f32)
    nf = DIFF_DK // 4
    inv = ROPE_BASE ** (-jnp.arange(nf, dtype=f32) / nf)
    ang = jnp.concatenate([r[:, None] * inv, col[:, None] * inv], axis=-1)
    return jnp.cos(ang), jnp.sin(ang)


def apply_rope(x, cos, sin):
    half = x.shape[-1] // 2
    x1, x2 = x[..., :half], x[..., half:]
    c = cos[:, None, None, :]
    s = sin[:, None, None, :]
    return jnp.concatenate([x1 * c - x2 * s, x1 * s + x2 * c], axis=-1).astype(x.dtype)


def gla_scan(q, k, v, log_a, s0):
    B, L, H, dk = q.shape
    dv = v.shape[-1]
    C = GLA_CHUNK
    nc = L // C
    qc = q.astype(f32).reshape(B, nc, C, H, dk)
    kc = k.astype(f32).reshape(B, nc, C, H, dk)
    vc = v.astype(f32).reshape(B, nc, C, H, dv)
    gc = log_a.astype(f32).reshape(B, nc, C, H, dk)
    b = jnp.cumsum(gc, axis=2)
    btot = b[:, :, -1]
    q_dec = qc * jnp.exp(b)
    att = jnp.einsum('bnihd,bnjhd->bnhij', q_dec, kc * jnp.exp(-b))
    att = jnp.where(jnp.tril(jnp.ones((C, C), bool)), att, 0.0)
    o_intra = jnp.einsum('bnhij,bnjhv->bnihv', att, vc)
    kv = jnp.einsum('bnjhd,bnjhv->bnhdv', kc * jnp.exp(btot[:, :, None] - b), vc)

    def step(S, xs):
        qd, kvc, bt = xs
        o = jnp.einsum('bihd,bhdv->bihv', qd, S)
        return jnp.exp(bt)[..., None] * S + kvc, o

    S_fin, o_inter = lax.scan(step, s0.astype(f32),
                              (jnp.moveaxis(q_dec, 1, 0), jnp.moveaxis(kv, 1, 0), jnp.moveaxis(btot, 1, 0)))
    o = o_intra + jnp.moveaxis(o_inter, 0, 1)
    return o.reshape(B, L, H, dv).astype(v.dtype), S_fin


def ssd_scan(x, dt, a, bm, cm, s0):
    B, L, H, P = x.shape
    N = bm.shape[-1]
    C = SSD_CHUNK
    nc = L // C
    rep = H // bm.shape[2]
    bh = jnp.repeat(bm, rep, axis=2).astype(f32).reshape(B, nc, C, H, N)
    ch = jnp.repeat(cm, rep, axis=2).astype(f32).reshape(B, nc, C, H, N)
    xc = x.astype(f32).reshape(B, nc, C, H, P)
    dtc = dt.astype(f32).reshape(B, nc, C, H)
    cum = jnp.cumsum(dtc * a, axis=2)
    causal = jnp.tril(jnp.ones((C, C), bool))[None, None, :, :, None]
    seg = cum[:, :, :, None, :] - cum[:, :, None, :, :]
    lmat = jnp.exp(jnp.where(causal, seg, -jnp.inf))
    w = jnp.einsum('bnihd,bnjhd->bnijh', ch, bh) * lmat * dtc[:, :, None, :, :]
    y_intra = jnp.einsum('bnijh,bnjhp->bnihp', w, xc)
    tail = jnp.exp(cum[:, :, -1:, :] - cum) * dtc
    st = jnp.einsum('bnjhd,bnjh,bnjhp->bnhpd', bh, tail, xc)
    chunk_decay = jnp.exp(cum[:, :, -1])
    c_dec = ch * jnp.exp(cum)[..., None]

    def step(S, xs):
        cd, stc, dec = xs
        y = jnp.einsum('bihd,bhpd->bihp', cd, S)
        return dec[:, :, None, None] * S + stc, y

    S_fin, y_inter = lax.scan(step, s0.astype(f32),
                              (jnp.moveaxis(c_dec, 1, 0), jnp.moveaxis(st, 1, 0), jnp.moveaxis(chunk_decay, 1, 0)))
    y = (y_intra + jnp.moveaxis(y_inter, 0, 1)).reshape(B, L, H, P)
    return y.astype(x.dtype), S_fin


def diff_attention(q, k, v, lam):
    B, Lq, H, _, dk = q.shape
    nb = Lq // Q_BLOCK
    qb = jnp.moveaxis(q.reshape(B, nb, Q_BLOCK, H, 2, dk), 1, 0)
    kf = k.astype(f32) * dk ** -0.5
    vf = v.astype(f32)

    def block(qblk):
        s = jnp.einsum('bqhcd,bkhcd->bhcqk', qblk.astype(f32), kf)
        pr = jax.nn.softmax(s, axis=-1)
        amap = pr[:, :, 0] - lam * pr[:, :, 1]
        return jnp.einsum('bhqk,bkhd->bqhd', amap, vf)

    o = lax.map(block, qb)
    return jnp.moveaxis(o, 0, 1).reshape(B, Lq, H, v.shape[-1]).astype(v.dtype)


def hyena_filters(L, p):
    t = (jnp.arange(L, dtype=f32) / L)[:, None]
    bands = jnp.arange(1, HY_BANDS + 1, dtype=f32)
    ang = 2.0 * math.pi * t * bands
    z = jnp.concatenate([t, jnp.cos(ang), jnp.sin(ang)], axis=-1)
    hdn = jnp.sin(p['hy_sin_w'] * (z @ p['hy_f_w1'] + p['hy_f_b1']))
    hdn = jnp.sin(p['hy_sin_w'] * (hdn @ p['hy_f_w2'] + p['hy_f_b2']))
    h = (hdn @ p['hy_f_w3'] + p['hy_f_b3']).astype(f32) * jnp.exp(-t * jnp.abs(p['hy_decay'].astype(f32)))
    h = h.reshape(L, 2, 2, HY_CH)
    return h / (jnp.sum(jnp.abs(h), axis=(0, 2), keepdims=True) + NORM_EPS)


def fft_long_conv(u, hf, hb, skip):
    L = u.shape[1]
    kern = jnp.concatenate([hf, jnp.zeros_like(hf[:1]), hb[:0:-1]], axis=0)
    kf = jnp.fft.rfft(kern, n=2 * L, axis=0)
    uf = jnp.fft.rfft(u.astype(f32), n=2 * L, axis=1)
    y = jnp.fft.irfft(uf * kf[None], n=2 * L, axis=1)[:, :L]
    return (y + u.astype(f32) * skip.astype(f32)).astype(u.dtype)


def mixer_block(u, p, lam_init, rope, ctx):
    B, L, _ = u.shape
    (gq, gk, gv, gg, gr, dq, dkk, dvv, sz, sxbc, sdt, hy) = split_cols(u @ p['w_in'], IN_SIZES)
    if ctx is None:
        gla_s0 = jnp.zeros((B, 2, GLA_H, GLA_DK, GLA_DV), f32)
        ssd_s0 = jnp.zeros((B, 2, SSD_H, SSD_P, SSD_N), f32)
    else:
        ctx_k, ctx_v, gla_s0, ssd_s0 = ctx

    q = gq.reshape(B, L, GLA_H, GLA_DK) * GLA_DK ** -0.5
    k = gk.reshape(B, L, GLA_H, GLA_DK)
    v = gv.reshape(B, L, GLA_H, GLA_DV)
    logits = jnp.einsum('bldr,drk->bldk', gr.reshape(B, L, 2, GLA_RANK), p['gla_gate_w']) + p['gla_gate_b']
    log_a = (jax.nn.log_sigmoid(logits.astype(f32)) / GLA_TAU).reshape(B, L, 2, GLA_H, GLA_DK)
    o_f, gsf = gla_scan(q, k, v, log_a[:, :, 0], gla_s0[:, 0])
    o_b, gsb = gla_scan(flip(q), flip(k), flip(v), flip(log_a[:, :, 1]), gla_s0[:, 1])
    o_gla = rms_norm(o_f + flip(o_b), p['gla_norm_g']).reshape(B, L, GLA_V) * jax.nn.silu(gg)

    q = dq.reshape(B, L, DIFF_H, 2, DIFF_DK)
    k = dkk.reshape(B, L, DIFF_H, 2, DIFF_DK)
    v = dvv.reshape(B, L, DIFF_H, DIFF_DV)
    if rope is not None:
        q = apply_rope(q, rope[0], rope[1])
        k = apply_rope(k, rope[0], rope[1])
    if ctx is None:
        keys, vals = k, v
    else:
        keys = jnp.concatenate([k, ctx_k.reshape(B, -1, DIFF_H, 2, DIFF_DK).astype(k.dtype)], axis=1)
        vals = jnp.concatenate([v, ctx_v.astype(v.dtype)], axis=1)
    lp = p['diff_lambda'].astype(f32)
    lam = jnp.exp(jnp.sum(lp[0] * lp[1])) - jnp.exp(jnp.sum(lp[2] * lp[3])) + lam_init
    o_diff = rms_norm(diff_attention(q, keys, vals, lam), p['diff_norm_g']) * (1.0 - lam_init)
    o_diff = o_diff.reshape(B, L, DIFF_V)

    xbc = jax.nn.silu(dwconv_centred(sxbc, p['ssd_conv_w'], p['ssd_conv_b']))
    xs, bm, cm = split_cols(xbc, (SSD_DI, SSD_BC, SSD_BC))
    xs = xs.reshape(B, L, SSD_H, SSD_P)
    bm = bm.reshape(B, L, SSD_G, SSD_N)
    cm = cm.reshape(B, L, SSD_G, SSD_N)
    dt = jax.nn.softplus(sdt.reshape(B, L, 2, SSD_H).astype(f32) + p['ssd_dt_bias'].astype(f32))
    a = -jnp.exp(p['ssd_a_log'].astype(f32))
    y_f, ssf = ssd_scan(xs, dt[:, :, 0], a[0], bm, cm, ssd_s0[:, 0])
    y_b, ssb = ssd_scan(flip(xs), flip(dt[:, :, 1]), a[1], flip(bm), flip(cm), ssd_s0[:, 1])
    y = y_f + flip(y_b) + xs * p['ssd_d'][:, None]
    o_ssd = rms_norm(y.reshape(B, L, SSD_DI) * jax.nn.silu(sz), p['ssd_norm_g'])

    hv, hx1, hx2 = split_cols(dwconv_centred(hy, p['hy_conv_w'], p['hy_conv_b']), (HY_CH, HY_CH, HY_CH))
    filt = hyena_filters(L, p)
    zz = hx1 * fft_long_conv(hv, filt[:, 0, 0], filt[:, 0, 1], p['hy_skip'][0])
    o_hy = hx2 * fft_long_conv(zz, filt[:, 1, 0], filt[:, 1, 1], p['hy_skip'][1])

    out = jnp.concatenate([o_gla, o_diff, o_ssd, o_hy], axis=-1) @ p['w_out']
    new_ctx = (k.reshape(B, L, DIFF_H, 2 * DIFF_DK), v,
               jnp.stack([gsf, gsb], axis=1), jnp.stack([ssf, ssb], axis=1))
    return out, new_ctx


def trunk_layer(x, cvec, p, lam_init, rope, ctx):
    sh1, sc1, g1, sh2, sc2, g2 = adaln(cvec, p['ada_w'], p['ada_b'])
    u = rms_norm(x, p['norm1_g']) * (1.0 + sc1) + sh1
    mix, new_ctx = mixer_block(u, p, lam_init, rope, ctx)
    x = x + g1 * mix
    u = rms_norm(x, p['norm2_g']) * (1.0 + sc2) + sh2
    x = x + g2 * (jnp.square(jax.nn.relu(u @ p['mlp_w1'])) @ p['mlp_w2'])
    return x, new_ctx


def setup_inputs(seed: int = 0) -> dict:
    key = jax.random.key(seed)
    ks = iter(jax.random.split(key, 48))

    def nrm(shape, scale):
        return jax.random.normal(next(ks), shape, f32) * scale

    def unif(shape, lo, hi):
        return jax.random.uniform(next(ks), shape, f32, lo, hi)

    dt0 = jnp.exp(unif((DEPTH, 2, SSD_H), math.log(1e-3), math.log(1e-1)))
    return {
        'x_prompt': nrm((BATCH, SEQ, D_MODEL), 1.0),
        'x_sample': nrm((DEC_BATCH, DEC_SEQ, D_MODEL), 1.0),
        'cache_diff_k': nrm((DEC_BATCH, DEPTH, PAST_LEN, DIFF_H, 2 * DIFF_DK), 1.0),
        'cache_diff_v': nrm((DEC_BATCH, DEPTH, PAST_LEN, DIFF_H, DIFF_DV), 1.0),
        'state_gla': nrm((DEC_BATCH, DEPTH, 2, GLA_H, GLA_DK, GLA_DV), 0.5),
        'state_ssd': nrm((DEC_BATCH, DEPTH, 2, SSD_H, SSD_P, SSD_N), 0.5),
        'c': nrm((DEC_BATCH, D_MODEL), 1.0),
        'c_ctx': nrm((D_MODEL,), 1.0),
        'ada_w': nrm((DEPTH, D_MODEL, 6 * D_MODEL), D_MODEL ** -0.5),
        'ada_b': nrm((DEPTH, 6 * D_MODEL), 0.02),
        'norm1_g': 1.0 + nrm((DEPTH, D_MODEL), 0.02),
        'norm2_g': 1.0 + nrm((DEPTH, D_MODEL), 0.02),
        'w_in': nrm((DEPTH, D_MODEL, IN_W), D_MODEL ** -0.5),
        'w_out': nrm((DEPTH, D_MODEL, D_MODEL), D_MODEL ** -0.5),
        'gla_gate_w': nrm((DEPTH, 2, GLA_RANK, GLA_QK), GLA_RANK ** -0.5),
        'gla_gate_b': nrm((DEPTH, 2, GLA_QK), 0.1),
        'gla_norm_g': 1.0 + nrm((DEPTH, GLA_DV), 0.02),
        'diff_lambda': nrm((DEPTH, 4, DIFF_DK), 0.1),
        'diff_norm_g': 1.0 + nrm((DEPTH, DIFF_DV), 0.02),
        'ssd_conv_w': nrm((DEPTH, SSD_CONV, SSD_XBC), SSD_CONV ** -0.5),
        'ssd_conv_b': nrm((DEPTH, SSD_XBC), 0.02),
        'ssd_dt_bias': dt0 + jnp.log(-jnp.expm1(-dt0)),
        'ssd_a_log': jnp.log(unif((DEPTH, 2, SSD_H), 1.0, 16.0)),
        'ssd_d': 1.0 + nrm((DEPTH, SSD_H), 0.1),
        'ssd_norm_g': 1.0 + nrm((DEPTH, SSD_DI), 0.02),
        'hy_conv_w': nrm((DEPTH, HY_SHORT, HY_W), HY_SHORT ** -0.5),
        'hy_conv_b': nrm((DEPTH, HY_W), 0.02),
        'hy_f_w1': nrm((DEPTH, HY_EMB, HY_HID), HY_EMB ** -0.5),
        'hy_f_b1': nrm((DEPTH, HY_HID), 0.1),
        'hy_f_w2': nrm((DEPTH, HY_HID, HY_HID), HY_HID ** -0.5),
        'hy_f_b2': nrm((DEPTH, HY_HID), 0.1),
        'hy_f_w3': nrm((DEPTH, HY_HID, 4 * HY_CH), HY_HID ** -0.5),
        'hy_f_b3': nrm((DEPTH, 4 * HY_CH), 0.1),
        'hy_sin_w': 1.0 + nrm((DEPTH, HY_HID), 0.1),
        'hy_decay': unif((DEPTH, 4 * HY_CH), 3.0, 15.0),
        'hy_skip': nrm((DEPTH, 2, HY_CH), 0.1),
        'mlp_w1': nrm((DEPTH, D_MODEL, D_FF), D_MODEL ** -0.5),
        'mlp_w2': nrm((DEPTH, D_FF, D_MODEL), D_FF ** -0.5),
        'final_g': 1.0 + nrm((D_MODEL,), 0.02),
    }


def reference(x_prompt, x_sample, cache_diff_k, cache_diff_v, state_gla, state_ssd, c, c_ctx,
              ada_w, ada_b, norm1_g, norm2_g, w_in, w_out,
              gla_gate_w, gla_gate_b, gla_norm_g, diff_lambda, diff_norm_g,
              ssd_conv_w, ssd_conv_b, ssd_dt_bias, ssd_a_log, ssd_d, ssd_norm_g,
              hy_conv_w, hy_conv_b, hy_f_w1, hy_f_b1, hy_f_w2, hy_f_b2, hy_f_w3, hy_f_b3,
              hy_sin_w, hy_decay, hy_skip, mlp_w1, mlp_w2, final_g):
    rope = axial_rope(x_sample.shape[1])
    hp = x_prompt
    hs = x_sample
    ks_, vs_, gs_, ss_ = [], [], [], []
    for l in range(DEPTH):
        p = dict(ada_w=ada_w[l], ada_b=ada_b[l], norm1_g=norm1_g[l], norm2_g=norm2_g[l],
                 w_in=w_in[l], w_out=w_out[l],
                 gla_gate_w=gla_gate_w[l], gla_gate_b=gla_gate_b[l], gla_norm_g=gla_norm_g[l],
                 diff_lambda=diff_lambda[l], diff_norm_g=diff_norm_g[l],
                 ssd_conv_w=ssd_conv_w[l], ssd_conv_b=ssd_conv_b[l], ssd_dt_bias=ssd_dt_bias[l],
                 ssd_a_log=ssd_a_log[l], ssd_d=ssd_d[l], ssd_norm_g=ssd_norm_g[l],
                 hy_conv_w=hy_conv_w[l], hy_conv_b=hy_conv_b[l], hy_f_w1=hy_f_w1[l], hy_f_b1=hy_f_b1[l],
                 hy_f_w2=hy_f_w2[l], hy_f_b2=hy_f_b2[l], hy_f_w3=hy_f_w3[l], hy_f_b3=hy_f_b3[l],
                 hy_sin_w=hy_sin_w[l], hy_decay=hy_decay[l], hy_skip=hy_skip[l],
                 mlp_w1=mlp_w1[l], mlp_w2=mlp_w2[l])
        lam_init = 0.8 - 0.6 * math.exp(-0.3 * l)
        hp, (k_l, v_l, g_l, s_l) = trunk_layer(hp, c_ctx[None], p, lam_init, None, None)
        ks_.append(k_l)
        vs_.append(v_l)
        gs_.append(g_l)
        ss_.append(s_l)
        hs, _ = trunk_layer(hs, c, p, lam_init, rope,
                            (cache_diff_k[:, l], cache_diff_v[:, l], state_gla[:, l], state_ssd[:, l]))
    y_prompt = rms_norm(hp, final_g)
    y_sample = rms_norm(hs, final_g)
    new_diff_k = jnp.stack(ks_, axis=1)
    new_diff_v = jnp.stack(vs_, axis=1)
    new_gla = jnp.stack(gs_, axis=1)
    new_ssd = jnp.stack(ss_, axis=1)
    return (y_prompt, y_sample, new_diff_k, new_diff_v, new_gla, new_ssd)
```

```cpp
#include <hip/hip_runtime.h>
#include <hip/hip_cooperative_groups.h>
#include <cstdio>
namespace cg = cooperative_groups;

#define DI __device__ __forceinline__
#define LAS __attribute__((address_space(3)))
typedef unsigned short bf16_t;
typedef short bf16x8 __attribute__((ext_vector_type(8)));
typedef short s16x4 __attribute__((ext_vector_type(4)));
typedef float f32x4 __attribute__((ext_vector_type(4)));
typedef float f32x16 __attribute__((ext_vector_type(16)));
typedef unsigned u32x4 __attribute__((ext_vector_type(4)));
typedef unsigned u32x2 __attribute__((ext_vector_type(2)));

constexpr int NTOK = 40960, NPT = 8192, DM = 2048, INW = 5936, INWP = 6144, DFF = 8192;
constexpr int C_GQ = 0, C_GK = 256, C_GV = 512, C_GG = 1024, C_GR = 1536, C_DQ = 1568, C_DK = 2080, C_DV = 2592, C_SZ = 3104, C_SX = 3616, C_SDT = 4384, C_HY = 4400;
constexpr size_t O_NK = 83886080, O_NV = 92274688, O_NG = 100663296, O_NS = 102760448;
constexpr size_t WS_PROJ = 0;
constexpr size_t WS_HVT = 486277120;
constexpr size_t WS_GLAF = WS_HVT + 83886080;
constexpr size_t WS_SSDF = WS_GLAF + 41943040;
constexpr size_t WS_UBUF = 671088640;
constexpr size_t WS_WIN = 838860800, WS_WOUT = WS_WIN + 25165824, WS_W1 = WS_WOUT + 8388608, WS_W2 = WS_W1 + 33554432;
constexpr size_t WS_KBUF = 939524096;
constexpr size_t WS_VTBUF = WS_KBUF + 46137344;
constexpr size_t WS_GR = WS_VTBUF + 46137344;
constexpr size_t WS_CTL = WS_GR + 17858560;
constexpr size_t CTL_MODS = 0, CTL_HYSUM = 884736, CTL_Q = CTL_HYSUM + 16384, CTL_BYTES = CTL_Q + 256;
constexpr size_t WS_BC = WS_CTL + CTL_BYTES;
constexpr size_t WS_END = WS_BC + 20971520;
constexpr size_t PK_OFF = 18874368;
constexpr size_t GRP_OFF = 8396800;
constexpr int LDS_MISC = 131072, LDS_BYTES = 131072 + 256;
constexpr int NPHASE = 20;

struct KArgs { const float* in[39]; float* out; unsigned char* ws; int ph_lo, ph_hi; };
struct Params { float* out; unsigned char* ws; };
typedef const volatile unsigned long long __attribute__((address_space(4)))* kargp_t;
__device__ __forceinline__ const float* inp(int k) { kargp_t ka = (kargp_t)__builtin_amdgcn_kernarg_segment_ptr(); return (const float*)ka[k]; }

DI float bf2f(bf16_t v) { return __uint_as_float(((unsigned)v) << 16); }
typedef float f32x2 __attribute__((ext_vector_type(2)));
typedef __bf16 hbf16x2 __attribute__((ext_vector_type(2)));
DI unsigned pk2(float lo, float hi) { f32x2 v = {lo, hi}; hbf16x2 b = __builtin_convertvector(v, hbf16x2); return __builtin_bit_cast(unsigned, b); }
DI bf16_t f2bf(float f) { return (bf16_t)(pk2(f, 0.f) & 0xffffu); }
DI float lo16(unsigned w) { return __uint_as_float(w << 16); }
DI float hi16(unsigned w) { return __uint_as_float(w & 0xffff0000u); }
DI float siluf(float x) { return x / (1.f + __expf(-x)); }
DI float sinr(float x) { return __builtin_amdgcn_sinf(x * 0.15915494309189535f); }
DI void unpack8(u32x4 w, float* v) { v[0] = lo16(w.x); v[1] = hi16(w.x); v[2] = lo16(w.y); v[3] = hi16(w.y); v[4] = lo16(w.z); v[5] = hi16(w.z); v[6] = lo16(w.w); v[7] = hi16(w.w); }
DI u32x4 pack8(const float* v) { u32x4 w; w.x = pk2(v[0], v[1]); w.y = pk2(v[2], v[3]); w.z = pk2(v[4], v[5]); w.w = pk2(v[6], v[7]); return w; }
DI f32x4 mma16(bf16x8 a, bf16x8 b, f32x4 c) { return __builtin_amdgcn_mfma_f32_16x16x32_bf16(a, b, c, 0, 0, 0); }
DI f32x16 mma32(bf16x8 a, bf16x8 b, f32x16 c) { return __builtin_amdgcn_mfma_f32_32x32x16_bf16(a, b, c, 0, 0, 0); }
DI bf16x8 ldfrag(const bf16_t* base, int row, int stride, int koff) { return *(const bf16x8*)(base + row * stride + koff); }

DI int otid() { int t = threadIdx.x; asm volatile("" : "+v"(t)); return t; }
struct Seq { int base, L, modrow, smp, b; };
DI Seq seq_of(int s) { Seq q; if (s < 32) { q.base = 256 * s; q.L = 256; q.modrow = 0; q.smp = 0; q.b = s; } else { q.b = s - 32; q.base = NPT + 4096 * q.b; q.L = 4096; q.modrow = 1 + q.b; q.smp = 1; } return q; }

namespace pg8 {
constexpr int BM = 256, BK = 64, HALF = 128, HTB = HALF * BK * 2, STAGE_BYTES = 8 * HTB, NXCD = 8, WGM = 8;
DI int lds_byte(int r, int c) { const int st = (r >> 4) * 2 + (c >> 5), rr = r & 15, cc = c & 31, ob = rr * 64 + cc * 2; return st * 1024 + (ob ^ (((ob >> 9) & 1) << 5)); }
DI void stage_rc(int b, int& R, int& C) { const int st = b / 1024, sb = b % 1024, swz = sb ^ (((sb >> 9) & 1) << 5); R = (st >> 1) * 16 + swz / 64; C = (st & 1) * 32 + (swz % 64) / 2; }
DI int perm32(int rho) { const int n = rho >> 4, i = rho & 15; return 8 * (i >> 2) + 4 * n + (i & 3); }
struct Unit { int pm, pn; };
struct Gemm { const bf16_t* A; const bf16_t* Bt; int M, N, K; };
struct StaticOrder {
    int nM, nN, nwg, G, c;
    DI void init(int M, int N, int G_, int c_) { nM = M / BM; nN = N / BM; nwg = nM * nN; G = G_; c = c_; }
    DI bool next(int i, Unit& u) const {
        const long L = (long)i * G + c; if (L >= nwg) return false;
        int wgid = (int)L; { const int q = nwg / NXCD, r = nwg % NXCD, xcd = wgid % NXCD, off = wgid / NXCD; wgid = (xcd < r ? xcd * (q + 1) : r * (q + 1) + (xcd - r) * q) + off; }
        const int nig = WGM * nN, gid = wgid / nig, fm = gid * WGM, gsz = (nM - fm) < WGM ? (nM - fm) : WGM;
        u.pm = fm + ((wgid % nig) % gsz); u.pn = (wgid % nig) / gsz; return true;
    }
};
DI unsigned cvt_pk_bf16(float lo, float hi) { unsigned r; asm volatile("v_cvt_pk_bf16_f32 %0, %1, %2" : "=v"(r) : "v"(lo), "v"(hi)); return r; }

struct EpiBf16 {
    static constexpr bool PERM = true;
    bf16_t* O; int ldc; int ncols; int act;
    DI void operator()(const f32x4 (&acc)[2][2][4][2], const Unit& u, int wr, int wc, int fr, int fq) const {
        int row0 = u.pm * BM + wr * 64 + fr; asm volatile("" : "+v"(row0)); const int col0 = u.pn * BM + wc * 32 + 8 * fq;
#pragma unroll
        for (int ai = 0; ai < 2; ++ai)
#pragma unroll
            for (int m = 0; m < 4; ++m) { bf16_t* rowp = O + (size_t)(row0 + ai * HALF + m * 16) * ldc + col0;
#pragma unroll
                for (int bj = 0; bj < 2; ++bj) { f32x4 v0 = acc[ai][bj][m][0], v1 = acc[ai][bj][m][1];
                    if (act == 1) {
#pragma unroll
                        for (int j = 0; j < 4; ++j) { const float a = fmaxf(v0[j], 0.f), b = fmaxf(v1[j], 0.f); v0[j] = a * a; v1[j] = b * b; } }
                    u32x4 w; w.x = cvt_pk_bf16(v0[0], v0[1]); w.y = cvt_pk_bf16(v0[2], v0[3]); w.z = cvt_pk_bf16(v1[0], v1[1]); w.w = cvt_pk_bf16(v1[2], v1[3]);
                    if (col0 + bj * HALF < ncols) *(u32x4*)(rowp + bj * HALF) = w; } }
    }
};
struct EpiRes {
    static constexpr bool PERM = false;
    const float* xin_p; const float* xin_s; float* out; const float* gate_l;
    DI void operator()(const f32x4 (&acc)[2][2][4][2], const Unit& u, int wr, int wc, int fr, int fq) const {
        const int tok0 = u.pm * BM; const int modrow = tok0 < NPT ? 0 : 1 + ((tok0 - NPT) >> 12);
        const float* xin = tok0 < NPT ? xin_p + (size_t)tok0 * DM : xin_s + (size_t)(tok0 - NPT) * DM;
        int rl0 = wr * 64 + fr; asm volatile("" : "+v"(rl0)); const int col0 = u.pn * BM + wc * 32 + 4 * fq;
        const float* gp = gate_l + (size_t)modrow * 12288 + col0;
        asm volatile("" ::: "memory");
        f32x4 gv[2][2];
#pragma unroll
        for (int bj = 0; bj < 2; ++bj)
#pragma unroll
            for (int n = 0; n < 2; ++n) gv[bj][n] = *(const f32x4*)(gp + bj * HALF + n * 16);
#pragma unroll
        for (int ai = 0; ai < 2; ++ai)
#pragma unroll
            for (int m = 0; m < 4; ++m) { const int rl = rl0 + ai * HALF + m * 16; const float* xr = xin + (size_t)rl * DM + col0; float* orow = out + (size_t)(tok0 + rl) * DM + col0;
#pragma unroll
                for (int bj = 0; bj < 2; ++bj)
#pragma unroll
                    for (int n = 0; n < 2; ++n) { const f32x4 xv = *(const f32x4*)(xr + bj * HALF + n * 16); *(f32x4*)(orow + bj * HALF + n * 16) = xv + gv[bj][n] * acc[ai][bj][m][n]; }
                if (m & 1) asm volatile("" ::: "memory"); }
    }
};

template <class Epi>
DI void gemm_phase(LAS unsigned char* lds, const Gemm g, const StaticOrder& S, const Epi& E) {
    const int tid = otid(), wid = __builtin_amdgcn_readfirstlane(tid >> 6), lane = tid & 63, wr = wid >> 2, wc = wid & 3, fr = lane & 15, fq = lane >> 4;
    const int K = g.K, nt = K / BK;
    unsigned voffA[2], voffB[2];
#pragma unroll
    for (int i = 0; i < 2; ++i) { int R, C; stage_rc(tid * 16 + i * 8192, R, C); const int Rb = Epi::PERM ? ((R & ~31) + perm32(R & 31)) : R;
        voffA[i] = (unsigned)(R * K + C) * 2u; voffB[i] = (unsigned)(Rb * K + C) * 2u; }
    const size_t kstep = (size_t)(BK * 2);
    const size_t hstep = (size_t)HALF * K * 2;
    const size_t tstep = 2 * hstep;
    const unsigned ldsw = (unsigned)wid * 1024u;
    const int aoff = lds_byte(wr * 64 + fr, fq * 8), boff = lds_byte(wc * 32 + fr, fq * 8);
#define PG8_SA(b, h) (((b) * 2 + (h)) * HTB)
#define PG8_SB(b, h) ((4 + (b) * 2 + (h)) * HTB)
#define PG8_STAGE(bufoff, gbase, voff) do { _Pragma("unroll") for (int _i = 0; _i < 2; ++_i) \
        __builtin_amdgcn_global_load_lds((const unsigned*)((const char*)(gbase) + (voff)[_i]), (LAS unsigned*)(lds + (bufoff) + ldsw + _i * 8192), 16, 0, 0); } while (0)
#define PG8_LDA(dst, b, h) do { _Pragma("unroll") for (int m = 0; m < 4; ++m) _Pragma("unroll") for (int k = 0; k < 2; ++k) dst[m][k] = *(const LAS bf16x8*)(lds + PG8_SA(b, h) + aoff + m * 2048 + k * 1024); } while (0)
#define PG8_LDB(dst, b, h) do { _Pragma("unroll") for (int n = 0; n < 2; ++n) _Pragma("unroll") for (int k = 0; k < 2; ++k) dst[n][k] = *(const LAS bf16x8*)(lds + PG8_SB(b, h) + boff + n * 2048 + k * 1024); } while (0)
#define PG8_MMA(ai, bj, At, Bt) do { __builtin_amdgcn_s_setprio(1); _Pragma("unroll") for (int m = 0; m < 4; ++m) _Pragma("unroll") for (int n = 0; n < 2; ++n) _Pragma("unroll") for (int k = 0; k < 2; ++k) \
        acc[ai][bj][m][n] = __builtin_amdgcn_mfma_f32_16x16x32_bf16(Bt[n][k], At[m][k], acc[ai][bj][m][n], 0, 0, 0); __builtin_amdgcn_s_setprio(0); } while (0)
#define PG8_WAIT_V(n) asm volatile("s_waitcnt vmcnt(" #n ")" ::: "memory")
#define PG8_WAIT_L(n) asm volatile("s_waitcnt lgkmcnt(" #n ")" ::: "memory")
#define PG8_BAR __builtin_amdgcn_s_barrier()
#define PG8_SCHED __builtin_amdgcn_sched_barrier(0)
    Unit cur, nxt; int ui = 0;
    if (!S.next(0, cur)) return;
    f32x4 acc[2][2][4][2];
#pragma unroll
    for (int a = 0; a < 2; ++a)
#pragma unroll
        for (int b = 0; b < 2; ++b)
#pragma unroll
            for (int m = 0; m < 4; ++m)
#pragma unroll
                for (int n = 0; n < 2; ++n) acc[a][b][m][n] = (f32x4){0.f, 0.f, 0.f, 0.f};
    bf16x8 At[4][2], B0[2][2], B1[2][2];
    const char* cA = (const char*)g.A + (size_t)cur.pm * tstep; const char* cB = (const char*)g.Bt + (size_t)cur.pn * tstep;
    PG8_STAGE(PG8_SB(0, 0), cB, voffB); PG8_STAGE(PG8_SA(0, 0), cA, voffA); PG8_STAGE(PG8_SB(0, 1), cB + hstep, voffB); PG8_STAGE(PG8_SA(0, 1), cA + hstep, voffA);
    if (wr == 1) PG8_BAR;
    PG8_WAIT_V(4); PG8_BAR;
    PG8_STAGE(PG8_SB(1, 0), cB + kstep, voffB); PG8_STAGE(PG8_SA(1, 0), cA + kstep, voffA); PG8_STAGE(PG8_SB(1, 1), cB + hstep + kstep, voffB);
    PG8_WAIT_V(6); PG8_BAR;
    for (;;) {
        const bool has_next = S.next(ui + 1, nxt);
        const char* nA = has_next ? (const char*)g.A + (size_t)nxt.pm * tstep : cA; const char* nB = has_next ? (const char*)g.Bt + (size_t)nxt.pn * tstep : cB;
        for (int t = 0; t < nt; t += 2) {
            const bool last = (t == nt - 2);
            const char* a1 = cA + (size_t)(t + 1) * kstep;
            const char* a2 = last ? nA : cA + (size_t)(t + 2) * kstep; const char* b2 = last ? nB : cB + (size_t)(t + 2) * kstep;
            const char* a3 = a2 + kstep; const char* b3 = b2 + kstep;
            PG8_LDB(B0, 0, 0); PG8_SCHED; PG8_LDA(At, 0, 0); PG8_STAGE(PG8_SA(1, 1), a1 + hstep, voffA);
            PG8_WAIT_L(8); PG8_BAR; PG8_WAIT_L(0); PG8_MMA(0, 0, At, B0); PG8_BAR; PG8_SCHED;
            PG8_LDB(B1, 0, 1); PG8_STAGE(PG8_SB(0, 0), b2, voffB);
            PG8_BAR; PG8_WAIT_L(0); PG8_MMA(0, 1, At, B1); PG8_BAR;
            PG8_LDA(At, 0, 1); PG8_STAGE(PG8_SA(0, 0), a2, voffA);
            PG8_BAR; PG8_WAIT_L(0); PG8_MMA(1, 0, At, B0); PG8_BAR; PG8_SCHED;
            PG8_STAGE(PG8_SB(0, 1), b2 + hstep, voffB);
            PG8_WAIT_V(6); PG8_BAR; PG8_MMA(1, 1, At, B1); PG8_BAR;
            PG8_LDB(B0, 1, 0); PG8_SCHED; PG8_LDA(At, 1, 0); PG8_STAGE(PG8_SA(0, 1), a2 + hstep, voffA);
            PG8_WAIT_L(8); PG8_BAR; PG8_WAIT_L(0); PG8_MMA(0, 0, At, B0); PG8_BAR; PG8_SCHED;
            PG8_LDB(B1, 1, 1); PG8_STAGE(PG8_SB(1, 0), b3, voffB);
            PG8_BAR; PG8_WAIT_L(0); PG8_MMA(0, 1, At, B1); PG8_BAR;
            PG8_LDA(At, 1, 1); PG8_STAGE(PG8_SA(1, 0), a3, voffA);
            PG8_BAR; PG8_WAIT_L(0); PG8_MMA(1, 0, At, B0); PG8_BAR; PG8_SCHED;
            PG8_STAGE(PG8_SB(1, 1), b3 + hstep, voffB);
            PG8_WAIT_V(6); PG8_BAR; PG8_MMA(1, 1, At, B1); PG8_BAR;
        }
        E(acc, cur, wr, wc, fr, fq);
        if (!has_next) break;
#pragma unroll
        for (int a = 0; a < 2; ++a)
#pragma unroll
            for (int b = 0; b < 2; ++b)
#pragma unroll
                for (int m = 0; m < 4; ++m)
#pragma unroll
                    for (int n = 0; n < 2; ++n) acc[a][b][m][n] = (f32x4){0.f, 0.f, 0.f, 0.f};
        cur = nxt; cA = nA; cB = nB; ++ui;
    }
    PG8_WAIT_V(0);
    if (wr == 0) PG8_BAR;
    PG8_BAR;
#undef PG8_SA
#undef PG8_SB
#undef PG8_STAGE
#undef PG8_LDA
#undef PG8_LDB
#undef PG8_MMA
#undef PG8_WAIT_V
#undef PG8_WAIT_L
#undef PG8_BAR
#undef PG8_SCHED
}
}


DI void ada_item(const Params& p, unsigned char* lds, int it) {
    float* sil = (float*)lds;
    const int t = otid();
    const int l = it / 96, r = it % 96, kc = r / 12, nc = r % 12;
    __syncthreads();
    for (int e = t; e < 9 * 256; e += 512) { const int rr = e >> 8, k = kc * 256 + (e & 255); const float c = rr == 0 ? inp(7)[k] : inp(6)[(rr - 1) * 2048 + k]; sil[e] = siluf(c); }
    __syncthreads();
    const int n = nc * 1024 + t * 2;
    const float* w = inp(8) + ((size_t)l * 2048 + kc * 256) * 12288 + n;
    float a0[9], a1[9];
#pragma unroll
    for (int rr = 0; rr < 9; ++rr) { a0[rr] = 0.f; a1[rr] = 0.f; }
#pragma unroll 16
    for (int k = 0; k < 256; ++k) { const float2 wv = *(const float2*)(w + (size_t)k * 12288);
#pragma unroll
        for (int rr = 0; rr < 9; ++rr) { const float s = sil[rr * 256 + k]; a0[rr] += s * wv.x; a1[rr] += s * wv.y; } }
    float* mods = (float*)(p.ws + WS_CTL + CTL_MODS) + (size_t)l * 9 * 12288;
    const float b0 = kc == 0 ? inp(9)[l * 12288 + n] : 0.f, b1 = kc == 0 ? inp(9)[l * 12288 + n + 1] : 0.f;
#pragma unroll
    for (int rr = 0; rr < 9; ++rr) { atomicAdd(&mods[rr * 12288 + n], a0[rr] + b0); atomicAdd(&mods[rr * 12288 + n + 1], a1[rr] + b1); }
}

DI void filter_tile(const Params& p, unsigned char* lds, int l, int grp, int pos0, int mode) {
    const int L = grp ? 4096 : 256;
    float* z = (float*)lds;
    float* h1 = z + 16 * 33;
    float* h2 = h1 + 16 * 64;
    const int t = otid();
    const float invL = 1.0f / (float)L;
    __syncthreads();
    for (int e = t; e < 16 * 33; e += 512) {
        const int ps = e / 33, k = e % 33, pp = pos0 + ps; float v;
        if (k == 0) v = (float)pp * invL;
        else { const int band = k <= 16 ? k : k - 16; const int ph = (pp * band) & (L - 1); const float rev = (float)ph * invL; v = k <= 16 ? __builtin_amdgcn_cosf(rev) : __builtin_amdgcn_sinf(rev); }
        z[e] = v;
    }
    __syncthreads();
    const float* w1 = inp(27) + l * 33 * 64; const float* b1 = inp(28) + l * 64; const float* w2 = inp(29) + l * 4096; const float* b2 = inp(30) + l * 64;
    const float* w3 = inp(31) + (size_t)l * 64 * 2048; const float* b3 = inp(32) + l * 2048; const float* sw = inp(33) + l * 64; const float* dec = inp(34) + l * 2048;
    for (int o = t; o < 1024; o += 512) { const int ps = o >> 6, j = o & 63; float s = b1[j];
#pragma unroll 11
        for (int k = 0; k < 33; ++k) s += z[ps * 33 + k] * w1[k * 64 + j]; h1[o] = sinr(sw[j] * s); }
    __syncthreads();
    for (int o = t; o < 1024; o += 512) { const int ps = o >> 6, j = o & 63; float s = b2[j];
#pragma unroll 16
        for (int k = 0; k < 64; ++k) s += h1[ps * 64 + k] * w2[k * 64 + j]; h2[o] = sinr(sw[j] * s); }
    __syncthreads();
    float acc[4][16];
#pragma unroll
    for (int q = 0; q < 4; ++q) { const float bb = b3[t + 512 * q];
#pragma unroll
        for (int ps = 0; ps < 16; ++ps) acc[q][ps] = bb; }
#pragma unroll 4
    for (int k = 0; k < 64; ++k) { float w[4];
#pragma unroll
        for (int q = 0; q < 4; ++q) w[q] = w3[k * 2048 + t + 512 * q];
#pragma unroll
        for (int ps = 0; ps < 16; ++ps) { const float hv = h2[ps * 64 + k];
#pragma unroll
            for (int q = 0; q < 4; ++q) acc[q][ps] += hv * w[q]; } }
    float* hysum = (float*)(p.ws + WS_CTL + CTL_HYSUM);
    bf16_t* GR = (bf16_t*)(p.ws + WS_GR) + (grp ? 0 : GRP_OFF);
    const int GRLEN = grp ? 8200 : 520;
#pragma unroll
    for (int q = 0; q < 4; ++q) {
        const int o = t + 512 * q; const float ad = fabsf(dec[o]); const int order = o >> 10, dir = (o >> 9) & 1, ch = o & 511;
        float* hs = hysum + ((l * 2 + grp) * 1024 + order * 512 + ch);
        if (mode == 0) { float s = 0.f;
#pragma unroll
            for (int ps = 0; ps < 16; ++ps) { const float tt = (float)(pos0 + ps) * invL; s += fabsf(acc[q][ps] * __expf(-tt * ad)); }
            atomicAdd(hs, s);
        } else { const float inv = 1.0f / (*hs + 1e-6f); bf16_t* gr = GR + (size_t)(order * 512 + ch) * GRLEN;
#pragma unroll
            for (int ps = 0; ps < 16; ++ps) { const int pp = pos0 + ps; const float tt = (float)pp * invL; const float hv = acc[q][ps] * __expf(-tt * ad) * inv;
                const int x = dir ? (L - 1 + pp) : (L - 1 - pp); if (!(dir && pp == 0)) gr[x] = f2bf(hv); }
        }
    }
}
DI void filter_item(const Params& p, unsigned char* lds, int l, int tile, int mode) {
    if (tile < 256) filter_tile(p, lds, l, 1, tile * 16, mode); else filter_tile(p, lds, l, 0, (tile - 256) * 16, mode);
}

DI void wconv_tile(const float* W, bf16_t* Wt, int K, int N, int kt, int nt, unsigned char* lds) {
    float* tile = (float*)lds;
    const int t = otid(), k0 = kt * 256, n0 = nt * 64;
    __syncthreads();
    float4 v[8];
#pragma unroll
    for (int i = 0; i < 8; ++i) { const int e = t + 512 * i, row = e >> 4, c4 = (e & 15) * 4, n = n0 + c4;
        v[i] = make_float4(0.f, 0.f, 0.f, 0.f); if (n < N) v[i] = *(const float4*)(W + (size_t)(k0 + row) * N + n); }
#pragma unroll
    for (int i = 0; i < 8; ++i) { const int e = t + 512 * i, row = e >> 4, c4 = (e & 15) * 4;
        float* tp = tile + row * 65 + c4; tp[0] = v[i].x; tp[1] = v[i].y; tp[2] = v[i].z; tp[3] = v[i].w; }
    __syncthreads();
    const int n = t >> 3;
#pragma unroll
    for (int q = 0; q < 4; ++q) { const int ks = (t & 7) * 8 + 64 * q; float o[8];
#pragma unroll
        for (int j = 0; j < 8; ++j) o[j] = tile[(ks + j) * 65 + n];
        *(u32x4*)(Wt + (size_t)(n0 + n) * K + k0 + ks) = pack8(o); }
}
DI void wconv_item(const Params& p, unsigned char* lds, int l, int it) {
    if (it < 768) wconv_tile(inp(12) + (size_t)l * DM * INW, (bf16_t*)(p.ws + WS_WIN), DM, INW, it / 96, it % 96, lds);
    else if (it < 1024) { it -= 768; wconv_tile(inp(13) + (size_t)l * DM * DM, (bf16_t*)(p.ws + WS_WOUT), DM, DM, it / 32, it % 32, lds); }
    else if (it < 2048) { it -= 1024; wconv_tile(inp(36) + (size_t)l * DM * DFF, (bf16_t*)(p.ws + WS_W1), DM, DFF, it / 128, it % 128, lds); }
    else { it -= 2048; wconv_tile(inp(37) + (size_t)l * DFF * DM, (bf16_t*)(p.ws + WS_W2), DFF, DM, it / 32, it % 32, lds); }
}

DI void ph_norm(const Params& p, int l, int which) {
    const int t = otid(), wave = t >> 6, lane = t & 63;
    const float* mods = (const float*)(p.ws + WS_CTL + CTL_MODS);
    bf16_t* ubuf = (bf16_t*)(p.ws + WS_UBUF);
    const float* xin0 = inp(0); const float* xin1 = inp(1);
    const float* g = which == 2 ? inp(38) : (which ? inp(11) : inp(10)) + l * DM;
    const int stride = gridDim.x * 8;
    for (int tok0 = blockIdx.x * 8 + wave; tok0 < NTOK; tok0 += 2 * stride) {
        f32x4 v[2][8]; float ss[2] = {0.f, 0.f};
#pragma unroll
        for (int u = 0; u < 2; ++u) { const int tok = tok0 + u * stride;
            const float* xr = (which == 0 && l == 0) ? (tok < NPT ? xin0 + (size_t)tok * DM : xin1 + (size_t)(tok - NPT) * DM) : p.out + (size_t)tok * DM;
            if (tok < NTOK) {
#pragma unroll
                for (int i = 0; i < 8; ++i) v[u][i] = *(const f32x4*)(xr + (i * 64 + lane) * 4); }
            else {
#pragma unroll
                for (int i = 0; i < 8; ++i) v[u][i] = (f32x4){0.f, 0.f, 0.f, 0.f}; } }
#pragma unroll
        for (int u = 0; u < 2; ++u) {
#pragma unroll
            for (int i = 0; i < 8; ++i) ss[u] += v[u][i][0] * v[u][i][0] + v[u][i][1] * v[u][i][1] + v[u][i][2] * v[u][i][2] + v[u][i][3] * v[u][i][3];
#pragma unroll
            for (int o = 32; o >= 1; o >>= 1) ss[u] += __shfl_xor(ss[u], o); }
#pragma unroll
        for (int u = 0; u < 2; ++u) { const int tok = tok0 + u * stride; if (tok >= NTOK) continue;
            const float rstd = rsqrtf(ss[u] * (1.0f / DM) + 1e-6f);
            if (which < 2) {
                const int modrow = tok < NPT ? 0 : 1 + ((tok - NPT) >> 12);
                const float* sh = mods + (size_t)(l * 9 + modrow) * 12288 + (which ? 3 : 0) * DM; const float* sc = sh + DM;
#pragma unroll
                for (int i = 0; i < 8; ++i) { const int col = (i * 64 + lane) * 4; const f32x4 gv = *(const f32x4*)(g + col), scv = *(const f32x4*)(sc + col), shv = *(const f32x4*)(sh + col);
                    const f32x4 uu = v[u][i] * rstd * gv * (scv + 1.0f) + shv; u32x2 w; w.x = pk2(uu[0], uu[1]); w.y = pk2(uu[2], uu[3]); *(u32x2*)(ubuf + (size_t)tok * DM + col) = w; }
            } else {
                float* orow = p.out + (size_t)tok * DM;
#pragma unroll
                for (int i = 0; i < 8; ++i) { const int col = (i * 64 + lane) * 4; const f32x4 gv = *(const f32x4*)(g + col); *(f32x4*)(orow + col) = v[u][i] * rstd * gv; }
            }
        }
    }
}

DI void tr_put(bf16_t* T, int i, int seg, const float* v) {
#pragma unroll
    for (int j = 0; j < 8; ++j) T[(seg + j) * 72 + i] = f2bf(v[j]);
}
DI u32x4 tr_get(const bf16_t* T, int r, int seg) { return *(const u32x4*)(T + r * 72 + seg); }

DI void kvprep_item(const Params& p, unsigned char* lds, int l, int tile) {
    bf16_t* T = (bf16_t*)lds;
    const int t = otid(), i = t >> 3, sub = t & 7, seg = sub * 8;
    const int tok0 = tile * 64, tok = tok0 + i;
    int smp, b, pos, Lk; if (tok < NPT) { smp = 0; b = tok >> 8; pos = tok & 255; Lk = 256; } else { smp = 1; b = (tok - NPT) >> 12; pos = (tok - NPT) & 4095; Lk = 4608; }
    const int pos0 = pos - i;
    const bf16_t* pr = (const bf16_t*)(p.ws + WS_PROJ) + (size_t)tok * INW;
    bf16_t* kbuf = (bf16_t*)(p.ws + WS_KBUF) + (smp ? 0 : PK_OFF);
    bf16_t* vtbuf = (bf16_t*)(p.ws + WS_VTBUF) + (smp ? 0 : PK_OFF);
    {
        const int head = sub; float kv[64];
#pragma unroll
        for (int q = 0; q < 8; ++q) unpack8(*(const u32x4*)(pr + C_DK + head * 64 + q * 8), kv + q * 8);
        if (!smp) { float* nk = p.out + O_NK + ((size_t)(b * 2 + l) * 256 + pos) * 512 + head * 64;
#pragma unroll
            for (int q = 0; q < 16; ++q) *(f32x4*)(nk + q * 4) = (f32x4){kv[q * 4], kv[q * 4 + 1], kv[q * 4 + 2], kv[q * 4 + 3]}; }
        else { const float frow = (float)(pos >> 6), fcol = (float)(pos & 63);
            const float inv[8] = {1.0f, 0.31622776601683794f, 0.1f, 0.031622776601683794f, 0.01f, 0.0031622776601683794f, 0.001f, 0.00031622776601683794f};
#pragma unroll
            for (int j = 0; j < 16; ++j) { const float ang = (j < 8 ? frow : fcol) * inv[j & 7]; const float rev = ang * 0.15915494309189535f; const float cs = __builtin_amdgcn_cosf(rev), sn = __builtin_amdgcn_sinf(rev);
#pragma unroll
                for (int c = 0; c < 2; ++c) { const float x1 = kv[c * 32 + j], x2 = kv[c * 32 + 16 + j]; kv[c * 32 + j] = x1 * cs - x2 * sn; kv[c * 32 + 16 + j] = x1 * sn + x2 * cs; } } }
        bf16_t* kd = kbuf + ((size_t)(b * 8 + head) * Lk + pos) * 64;
#pragma unroll
        for (int q = 0; q < 8; ++q) *(u32x4*)(kd + q * 8) = pack8(kv + q * 8);
    }
    bf16_t* T1 = T + 64 * 72;
    for (int head = 0; head < 8; head += 2) {
        float v[8], v1[8]; unpack8(*(const u32x4*)(pr + C_DV + head * 64 + seg), v); unpack8(*(const u32x4*)(pr + C_DV + (head + 1) * 64 + seg), v1);
        if (!smp) { float* nv = p.out + O_NV + ((size_t)(b * 2 + l) * 256 + pos) * 512 + head * 64 + seg; *(f32x4*)nv = (f32x4){v[0], v[1], v[2], v[3]}; *(f32x4*)(nv + 4) = (f32x4){v[4], v[5], v[6], v[7]};
            *(f32x4*)(nv + 64) = (f32x4){v1[0], v1[1], v1[2], v1[3]}; *(f32x4*)(nv + 68) = (f32x4){v1[4], v1[5], v1[6], v1[7]}; }
        __syncthreads();
        tr_put(T, i, seg, v); tr_put(T1, i, seg, v1);
        __syncthreads();
        *(u32x4*)(vtbuf + ((size_t)(b * 8 + head) * 64 + i) * Lk + pos0 + seg) = tr_get(T, i, seg);
        *(u32x4*)(vtbuf + ((size_t)(b * 8 + head + 1) * 64 + i) * Lk + pos0 + seg) = tr_get(T1, i, seg);
    }
}
DI void ctxprep_item(const Params& p, unsigned char* lds, int l, int it) {
    bf16_t* T = (bf16_t*)lds;
    const int t = otid(), i = t >> 3, sub = t & 7, seg = sub * 8;
    const int b = it >> 3, pt = it & 7, pp = pt * 64 + i;
    bf16_t* kbuf = (bf16_t*)(p.ws + WS_KBUF); bf16_t* vtbuf = (bf16_t*)(p.ws + WS_VTBUF);
    { const int head = sub; const float* src = inp(2) + ((size_t)(b * 2 + l) * 512 + pp) * 512 + head * 64; bf16_t* kd = kbuf + ((size_t)(b * 8 + head) * 4608 + 4096 + pp) * 64;
#pragma unroll
      for (int q = 0; q < 8; ++q) { const f32x4 a = *(const f32x4*)(src + q * 8), c = *(const f32x4*)(src + q * 8 + 4); u32x4 w; w.x = pk2(a[0], a[1]); w.y = pk2(a[2], a[3]); w.z = pk2(c[0], c[1]); w.w = pk2(c[2], c[3]); *(u32x4*)(kd + q * 8) = w; } }
    for (int head = 0; head < 8; ++head) {
        const float* src = inp(3) + ((size_t)(b * 2 + l) * 512 + pp) * 512 + head * 64 + seg; const f32x4 a = *(const f32x4*)src, c = *(const f32x4*)(src + 4);
        float v[8] = {a[0], a[1], a[2], a[3], c[0], c[1], c[2], c[3]};
        __syncthreads();
        tr_put(T, i, seg, v);
        __syncthreads();
        *(u32x4*)(vtbuf + ((size_t)(b * 8 + head) * 64 + i) * 4608 + 4096 + pt * 64 + seg) = tr_get(T, i, seg);
    }
}
DI void conv3x8(const bf16_t* proj, int tok, int pos, int L, int col, const float* w  , int ldw, const float* bias, float* out) {
    const bf16_t* pr = proj + (size_t)tok * INW + col;
    float xm[8], x0[8], xp[8];
    unpack8(*(const u32x4*)pr, x0);
    if (pos > 0) unpack8(*(const u32x4*)(pr - INW), xm); else {
#pragma unroll
        for (int j = 0; j < 8; ++j) xm[j] = 0.f; }
    if (pos < L - 1) unpack8(*(const u32x4*)(pr + INW), xp); else {
#pragma unroll
        for (int j = 0; j < 8; ++j) xp[j] = 0.f; }
    const f32x4 w0a = *(const f32x4*)w, w0b = *(const f32x4*)(w + 4), w1a = *(const f32x4*)(w + ldw), w1b = *(const f32x4*)(w + ldw + 4), w2a = *(const f32x4*)(w + 2 * ldw), w2b = *(const f32x4*)(w + 2 * ldw + 4);
    const f32x4 ba = *(const f32x4*)bias, bb = *(const f32x4*)(bias + 4);
#pragma unroll
    for (int j = 0; j < 4; ++j) { out[j] = ba[j] + w0a[j] * xm[j] + w1a[j] * x0[j] + w2a[j] * xp[j]; out[4 + j] = bb[j] + w0b[j] * xm[4 + j] + w1b[j] * x0[4 + j] + w2b[j] * xp[4 + j]; }
}
DI void hyprep_item(const Params& p, unsigned char* lds, int l, int tile) {
    bf16_t* T = (bf16_t*)lds;
    const int t = otid(), i = t >> 3, seg = (t & 7) * 8;
    const int tok0 = tile * 64, tok = tok0 + i;
    int pos, L; if (tok < NPT) { pos = tok & 255; L = 256; } else { pos = (tok - NPT) & 4095; L = 4096; }
    const bf16_t* proj = (const bf16_t*)(p.ws + WS_PROJ);
    bf16_t* hvt = (bf16_t*)(p.ws + WS_HVT);
    const float* cw = inp(25) + (size_t)l * 3 * 1536; const float* cb = inp(26) + l * 1536;
    bf16_t* T1 = T + 64 * 72;
    for (int cgp = 0; cgp < 16; cgp += 2) {
        float v[8], v1[8]; conv3x8(proj, tok, pos, L, C_HY + cgp * 64 + seg, cw + cgp * 64 + seg, 1536, cb + cgp * 64 + seg, v);
        conv3x8(proj, tok, pos, L, C_HY + (cgp + 1) * 64 + seg, cw + (cgp + 1) * 64 + seg, 1536, cb + (cgp + 1) * 64 + seg, v1);
        __syncthreads();
        tr_put(T, i, seg, v); tr_put(T1, i, seg, v1);
        __syncthreads();
        *(u32x4*)(hvt + (size_t)(cgp * 64 + i) * NTOK + tok0 + seg) = tr_get(T, i, seg);
        *(u32x4*)(hvt + (size_t)((cgp + 1) * 64 + i) * NTOK + tok0 + seg) = tr_get(T1, i, seg);
    }
}
DI void xbcprep_item(const Params& p, unsigned char* lds, int l, int tile) {
    const int t = otid(), i = t >> 3, seg = (t & 7) * 8;
    const int tok = tile * 64 + i;
    int pos, L; if (tok < NPT) { pos = tok & 255; L = 256; } else { pos = (tok - NPT) & 4095; L = 4096; }
    const bf16_t* proj = (const bf16_t*)(p.ws + WS_PROJ);
    bf16_t* mix = (bf16_t*)(p.ws + WS_UBUF) + (size_t)tok * DM + 1536; bf16_t* bc = (bf16_t*)(p.ws + WS_BC) + (size_t)tok * 256;
    const float* cw = inp(19) + (size_t)l * 3 * 768; const float* cb = inp(20) + l * 768;
#pragma unroll 2
    for (int cgp = 0; cgp < 12; ++cgp) { float v[8]; conv3x8(proj, tok, pos, L, C_SX + cgp * 64 + seg, cw + cgp * 64 + seg, 768, cb + cgp * 64 + seg, v);
#pragma unroll
        for (int j = 0; j < 8; ++j) v[j] = siluf(v[j]);
        if (cgp < 8) *(u32x4*)(mix + cgp * 64 + seg) = pack8(v); else *(u32x4*)(bc + (cgp - 8) * 64 + seg) = pack8(v); }
}
DI void gla_item(const Params& p, unsigned char* lds, int l, int s, int head, int dir) {
    const Seq sq = seq_of(s);
    bf16_t* LB = (bf16_t*)lds;
    bf16_t* RAW = LB;
    bf16_t* QD = LB + 22528;
    bf16_t* KD = LB + 25088;
    bf16_t* K2T = LB + 27648;
    bf16_t* VT = LB + 29952;
    bf16_t* ATT = LB + 34560;
    bf16_t* ST = LB + 39168;
    float* BTOT = (float*)(lds + 88576);
    float* GW = (float*)(lds + 88704);
    float* GB = (float*)(lds + 90752);
    const int t = otid(), wave = t >> 6, lane = t & 63, li = lane & 15, lg = lane >> 4;
    const bf16_t* proj = (const bf16_t*)(p.ws + WS_PROJ);
    bf16_t* dst = dir ? (bf16_t*)(p.ws + WS_UBUF) + head * 64 : (bf16_t*)(p.ws + WS_GLAF) + head * 64;
    const int dstride = dir ? DM : 512;
    const int nc = sq.L >> 6;
    const int dt = wave >> 2, vt = wave & 3;
    int pfi[3], pfc[3], pfl[3]; bool pfv[3];
#pragma unroll
    for (int j = 0; j < 3; ++j) { const int e = t + 512 * j; pfv[j] = e < 1152; const int ee = pfv[j] ? e : 0; const int i = ee / 18, part = ee - 18 * i; pfi[j] = i;
        if (part < 4) { pfc[j] = C_GQ + head * 32 + part * 8; pfl[j] = i * 40 + part * 8; }
        else if (part < 8) { pfc[j] = C_GK + head * 32 + (part - 4) * 8; pfl[j] = 2560 + i * 40 + (part - 4) * 8; }
        else if (part < 16) { pfc[j] = C_GV + head * 64 + (part - 8) * 8; pfl[j] = 5120 + i * 72 + (part - 8) * 8; }
        else { pfc[j] = C_GR + dir * 16 + (part - 16) * 8; pfl[j] = 9728 + i * 24 + (part - 16) * 8; } }
    u32x4 pre[3];
#pragma unroll
    for (int j = 0; j < 3; ++j) { const int sp = pfi[j]; const int pos = dir ? sq.L - 1 - sp : sp; pre[j] = (u32x4){0u, 0u, 0u, 0u}; if (pfv[j]) pre[j] = *(const u32x4*)(proj + (size_t)(sq.base + pos) * INW + pfc[j]); }
    f32x4 Sacc = (f32x4){0.f, 0.f, 0.f, 0.f};
    if (sq.smp) { const float* s0 = inp(4) + ((size_t)((sq.b * 2 + l) * 2 + dir) * 8 + head) * 2048;
#pragma unroll
        for (int j = 0; j < 4; ++j) Sacc[j] = s0[(16 * dt + 4 * lg + j) * 64 + 16 * vt + li]; }
    __syncthreads();
    float gwr[4][16], gbr[4];
    { const float* gwp = inp(14) + (size_t)(l * 2 + dir) * 16 * 256 + head * 32 + 4 * wave; const float* gbp = inp(15) + (l * 2 + dir) * 256 + head * 32 + 4 * wave;
#pragma unroll
      for (int dd = 0; dd < 4; ++dd) { gbr[dd] = gbp[dd];
#pragma unroll
          for (int r = 0; r < 16; ++r) gwr[dd][r] = gwp[r * 256 + dd]; } }
    { u32x2 w; w.x = pk2(Sacc[0], Sacc[1]); w.y = pk2(Sacc[2], Sacc[3]); *(u32x2*)(ST + (16 * vt + li) * 40 + 16 * dt + 4 * lg) = w; }
    for (int c = 0; c < nc; ++c) {
        const int cur = c & 1;
        bf16_t* RQ = RAW + cur * 11264; const bf16_t* RK = RQ + 2560; const bf16_t* RV = RQ + 5120; const bf16_t* RG = RQ + 9728;
        const bf16_t* STc = ST + cur * 2560; bf16_t* STn = ST + (cur ^ 1) * 2560;
#pragma unroll
        for (int j = 0; j < 3; ++j) if (pfv[j]) *(u32x4*)(RQ + pfl[j]) = pre[j];
        __syncthreads();
        if (c + 1 < nc) {
#pragma unroll
            for (int j = 0; j < 3; ++j) { const int sp = 64 * (c + 1) + pfi[j]; const int pos = dir ? sq.L - 1 - sp : sp; if (pfv[j]) pre[j] = *(const u32x4*)(proj + (size_t)(sq.base + pos) * INW + pfc[j]); } }
        { float gr[16]; unpack8(*(const u32x4*)(RG + lane * 24), gr); unpack8(*(const u32x4*)(RG + lane * 24 + 8), gr + 8);
          const u32x2 qw = *(const u32x2*)(RQ + lane * 40 + 4 * wave), kw = *(const u32x2*)(RK + lane * 40 + 4 * wave);
          const float qv[4] = {lo16(qw.x), hi16(qw.x), lo16(qw.y), hi16(qw.y)}, kv[4] = {lo16(kw.x), hi16(kw.x), lo16(kw.y), hi16(kw.y)};
          float qd[4], kd[4];
#pragma unroll
          for (int dd = 0; dd < 4; ++dd) { const int d = 4 * wave + dd; float x = gbr[dd];
#pragma unroll
              for (int r = 0; r < 16; ++r) x += gr[r] * gwr[dd][r];
              float v = (fminf(x, 0.f) - __logf(1.0f + __expf(-fabsf(x)))) * 0.0625f;
#pragma unroll
              for (int off = 1; off < 64; off <<= 1) { const float u = __shfl_up(v, off); if (lane >= off) v += u; }
              const float bt = __shfl(v, 63);
              if (lane == 63) BTOT[d] = bt;
              qd[dd] = qv[dd] * 0.17677669529663687f * __expf(v); kd[dd] = kv[dd] * __expf(-v);
              K2T[d * 72 + lane] = f2bf(kv[dd] * __expf(bt - v)); }
          u32x2 w; w.x = pk2(qd[0], qd[1]); w.y = pk2(qd[2], qd[3]); *(u32x2*)(QD + lane * 40 + 4 * wave) = w;
          w.x = pk2(kd[0], kd[1]); w.y = pk2(kd[2], kd[3]); *(u32x2*)(KD + lane * 40 + 4 * wave) = w; }
        { const int v = lane, j0 = 8 * wave; u32x4 w;
          w.x = (unsigned)RV[(j0 + 0) * 72 + v] | ((unsigned)RV[(j0 + 1) * 72 + v] << 16); w.y = (unsigned)RV[(j0 + 2) * 72 + v] | ((unsigned)RV[(j0 + 3) * 72 + v] << 16);
          w.z = (unsigned)RV[(j0 + 4) * 72 + v] | ((unsigned)RV[(j0 + 5) * 72 + v] << 16); w.w = (unsigned)RV[(j0 + 6) * 72 + v] | ((unsigned)RV[(j0 + 7) * 72 + v] << 16);
          *(u32x4*)(VT + v * 72 + j0) = w; }
        __syncthreads();
#pragma unroll
        for (int tt = 0; tt < 2; ++tt) { const int id = wave + 8 * tt, it = id >> 2, jt = id & 3;
            f32x4 cacc = (f32x4){0.f, 0.f, 0.f, 0.f};
            if (jt <= it) cacc = mma16(ldfrag(KD, 16 * jt + li, 40, 8 * lg), ldfrag(QD, 16 * it + li, 40, 8 * lg), cacc);
            const int row = 16 * it + li; float av[4];
#pragma unroll
            for (int j = 0; j < 4; ++j) { const int col = 16 * jt + 4 * lg + j; av[j] = col <= row ? cacc[j] : 0.f; }
            u32x2 w; w.x = pk2(av[0], av[1]); w.y = pk2(av[2], av[3]); *(u32x2*)(ATT + row * 72 + 16 * jt + 4 * lg) = w; }
        __syncthreads();
#pragma unroll
        for (int tt = 0; tt < 2; ++tt) { const int id = wave + 8 * tt, v2 = id >> 2, it = id & 3;
            f32x4 o = (f32x4){0.f, 0.f, 0.f, 0.f};
#pragma unroll
            for (int ks = 0; ks < 2; ++ks) o = mma16(ldfrag(VT, 16 * v2 + li, 72, 32 * ks + 8 * lg), ldfrag(ATT, 16 * it + li, 72, 32 * ks + 8 * lg), o);
            o = mma16(ldfrag(STc, 16 * v2 + li, 40, 8 * lg), ldfrag(QD, 16 * it + li, 40, 8 * lg), o);
            const int i = 16 * it + li; const int sp = 64 * c + i; const int pos = dir ? sq.L - 1 - sp : sp; const size_t tok = (size_t)(sq.base + pos);
            u32x2 w; w.x = pk2(o[0], o[1]); w.y = pk2(o[2], o[3]); *(u32x2*)(dst + tok * dstride + 16 * v2 + 4 * lg) = w; }
#pragma unroll
        for (int j = 0; j < 4; ++j) Sacc[j] *= __expf(BTOT[16 * dt + 4 * lg + j]);
#pragma unroll
        for (int ks = 0; ks < 2; ++ks) Sacc = mma16(ldfrag(K2T, 16 * dt + li, 72, 32 * ks + 8 * lg), ldfrag(VT, 16 * vt + li, 72, 32 * ks + 8 * lg), Sacc);
        { u32x2 w; w.x = pk2(Sacc[0], Sacc[1]); w.y = pk2(Sacc[2], Sacc[3]); *(u32x2*)(STn + (16 * vt + li) * 40 + 16 * dt + 4 * lg) = w; }
    }
    if (!sq.smp) { float* ng = p.out + O_NG + ((size_t)((sq.b * 2 + l) * 2 + dir) * 8 + head) * 2048;
#pragma unroll
        for (int j = 0; j < 4; ++j) ng[(16 * dt + 4 * lg + j) * 64 + 16 * vt + li] = Sacc[j]; }
}

DI void ssd_item(const Params& p, unsigned char* lds, int l, int s, int head, int dir) {
    const Seq sq = seq_of(s);
    bf16_t* LB = (bf16_t*)lds;
    bf16_t* RAW = LB;
    bf16_t* XT = LB + 27648;
    bf16_t* BST = LB + 32256;
    bf16_t* W = LB + 36864;
    bf16_t* SB = LB + 41472;
    float* CUMW = (float*)(lds + 101376);
    float* RDT = (float*)(lds + 107520);
    const int t = otid(), wave = t >> 6, lane = t & 63, li = lane & 15, lg = lane >> 4;
    const bf16_t* proj = (const bf16_t*)(p.ws + WS_PROJ);
    const bf16_t* xsrc = (const bf16_t*)(p.ws + WS_UBUF) + 1536 + head * 64;
    const int grp = head >> 2;
    const bf16_t* bcsrc = (const bf16_t*)(p.ws + WS_BC) + grp * 64;
    bf16_t* dst = dir ? (bf16_t*)(p.ws + WS_UBUF) + 1024 + head * 64 : (bf16_t*)(p.ws + WS_SSDF) + head * 64;
    const int dstride = dir ? DM : 512;
    const int nc = sq.L >> 6;
    const float av = -__expf(inp(22)[(l * 2 + dir) * 8 + head]);
    const float dtb = inp(21)[(l * 2 + dir) * 8 + head];
    const float dco = dir ? inp(23)[l * 8 + head] : 0.f;
    float* cw = CUMW + wave * 192;
    int pfi[3], pfl[3], pfs[3]; const bf16_t* pfb[3];
#pragma unroll
    for (int j = 0; j < 3; ++j) { const int e = t + 512 * j; const int i = e / 24, part = e - 24 * i, arr = part >> 3, seg = (part & 7) * 8; pfi[j] = i; pfl[j] = arr * 4608 + i * 72 + seg;
        pfb[j] = arr == 0 ? xsrc + seg : bcsrc + (arr - 1) * 128 + seg; pfs[j] = arr == 0 ? DM : 256; }
    u32x4 pre[3]; bf16_t predt = 0;
#pragma unroll
    for (int j = 0; j < 3; ++j) { const int sp = pfi[j]; const int pos = dir ? sq.L - 1 - sp : sp; pre[j] = *(const u32x4*)(pfb[j] + (size_t)(sq.base + pos) * pfs[j]); }
    if (t < 64) { const int pos = dir ? sq.L - 1 - t : t; predt = proj[(size_t)(sq.base + pos) * INW + C_SDT + dir * 8 + head]; }
    f32x4 Sacc[2];
#pragma unroll
    for (int tt = 0; tt < 2; ++tt) { const int id = wave + 8 * tt, pt = id >> 2, nt = id & 3; Sacc[tt] = (f32x4){0.f, 0.f, 0.f, 0.f};
        if (sq.smp) { const float* s0 = inp(5) + ((size_t)((sq.b * 2 + l) * 2 + dir) * 8 + head) * 4096; Sacc[tt] = *(const f32x4*)(s0 + (16 * pt + li) * 64 + 16 * nt + 4 * lg); } }
    __syncthreads();
#pragma unroll
    for (int tt = 0; tt < 2; ++tt) { const int id = wave + 8 * tt, pt = id >> 2, nt = id & 3;
        u32x2 w; w.x = pk2(Sacc[tt][0], Sacc[tt][1]); w.y = pk2(Sacc[tt][2], Sacc[tt][3]); *(u32x2*)(SB + (16 * pt + li) * 72 + 16 * nt + 4 * lg) = w; }
    for (int c = 0; c < nc; ++c) {
        const int cur = c & 1;
        bf16_t* RX = RAW + cur * 13824; bf16_t* RB = RX + 4608; bf16_t* RC = RX + 9216;
        const bf16_t* SBc = SB + cur * 4608; bf16_t* SBn = SB + (cur ^ 1) * 4608;
#pragma unroll
        for (int j = 0; j < 3; ++j) *(u32x4*)(RX + pfl[j]) = pre[j];
        if (t < 64) RDT[cur * 64 + t] = bf2f(predt);
        __syncthreads();
        if (c + 1 < nc) {
#pragma unroll
            for (int j = 0; j < 3; ++j) { const int sp = 64 * (c + 1) + pfi[j]; const int pos = dir ? sq.L - 1 - sp : sp; pre[j] = *(const u32x4*)(pfb[j] + (size_t)(sq.base + pos) * pfs[j]); }
            if (t < 64) { const int sp = 64 * (c + 1) + t; const int pos = dir ? sq.L - 1 - sp : sp; predt = proj[(size_t)(sq.base + pos) * INW + C_SDT + dir * 8 + head]; } }
        float dec;
        { const float xr = RDT[cur * 64 + lane] + dtb; const float dtv = xr > 20.f ? xr : __logf(1.0f + __expf(xr));
          float v = dtv * av;
#pragma unroll
          for (int off = 1; off < 64; off <<= 1) { const float u = __shfl_up(v, off); if (lane >= off) v += u; }
          const float cumL = __shfl(v, 63); dec = __expf(cumL);
          cw[lane] = v; cw[64 + lane] = dtv; cw[128 + lane] = __expf(cumL - v) * dtv; }
        { const int ch = lane, j0 = 8 * wave; float xv[8], bv[8];
#pragma unroll
          for (int n = 0; n < 8; ++n) { xv[n] = bf2f(RX[(j0 + n) * 72 + ch]); bv[n] = bf2f(RB[(j0 + n) * 72 + ch]) * cw[128 + j0 + n]; }
          *(u32x4*)(XT + ch * 72 + j0) = pack8(xv); *(u32x4*)(BST + ch * 72 + j0) = pack8(bv); }
#pragma unroll
        for (int tt = 0; tt < 2; ++tt) { const int id = wave + 8 * tt, it = id >> 2, jt = id & 3;
            f32x4 cacc = (f32x4){0.f, 0.f, 0.f, 0.f};
            if (jt <= it) {
#pragma unroll
                for (int ks = 0; ks < 2; ++ks) cacc = mma16(ldfrag(RB, 16 * jt + li, 72, 32 * ks + 8 * lg), ldfrag(RC, 16 * it + li, 72, 32 * ks + 8 * lg), cacc); }
            const int row = 16 * it + li; const float ci = cw[row]; float wv[4];
#pragma unroll
            for (int j = 0; j < 4; ++j) { const int col = 16 * jt + 4 * lg + j; wv[j] = col <= row ? cacc[j] * __expf(ci - cw[col]) * cw[64 + col] : 0.f; }
            u32x2 w; w.x = pk2(wv[0], wv[1]); w.y = pk2(wv[2], wv[3]); *(u32x2*)(W + row * 72 + 16 * jt + 4 * lg) = w; }
        __syncthreads();
#pragma unroll
        for (int tt = 0; tt < 2; ++tt) { const int id = wave + 8 * tt, pt = id >> 2, it = id & 3;
            f32x4 y1 = (f32x4){0.f, 0.f, 0.f, 0.f}, y2 = (f32x4){0.f, 0.f, 0.f, 0.f};
#pragma unroll
            for (int ks = 0; ks < 2; ++ks) { y1 = mma16(ldfrag(XT, 16 * pt + li, 72, 32 * ks + 8 * lg), ldfrag(W, 16 * it + li, 72, 32 * ks + 8 * lg), y1);
                y2 = mma16(ldfrag(SBc, 16 * pt + li, 72, 32 * ks + 8 * lg), ldfrag(RC, 16 * it + li, 72, 32 * ks + 8 * lg), y2); }
            const int i = 16 * it + li; const float ei = __expf(cw[i]);
            const int sp = 64 * c + i; const int pos = dir ? sq.L - 1 - sp : sp; const size_t tok = (size_t)(sq.base + pos);
            const u32x2 xw = *(const u32x2*)(RX + i * 72 + 16 * pt + 4 * lg);
            u32x2 w; w.x = pk2(y1[0] + ei * y2[0] + dco * lo16(xw.x), y1[1] + ei * y2[1] + dco * hi16(xw.x)); w.y = pk2(y1[2] + ei * y2[2] + dco * lo16(xw.y), y1[3] + ei * y2[3] + dco * hi16(xw.y));
            *(u32x2*)(dst + tok * dstride + 16 * pt + 4 * lg) = w; }
#pragma unroll
        for (int tt = 0; tt < 2; ++tt) { const int id = wave + 8 * tt, pt = id >> 2, nt = id & 3;
#pragma unroll
            for (int j = 0; j < 4; ++j) Sacc[tt][j] *= dec;
#pragma unroll
            for (int ks = 0; ks < 2; ++ks) Sacc[tt] = mma16(ldfrag(BST, 16 * nt + li, 72, 32 * ks + 8 * lg), ldfrag(XT, 16 * pt + li, 72, 32 * ks + 8 * lg), Sacc[tt]);
            u32x2 w; w.x = pk2(Sacc[tt][0], Sacc[tt][1]); w.y = pk2(Sacc[tt][2], Sacc[tt][3]); *(u32x2*)(SBn + (16 * pt + li) * 72 + 16 * nt + 4 * lg) = w; }
    }
    if (!sq.smp) { float* ns = p.out + O_NS + ((size_t)((sq.b * 2 + l) * 2 + dir) * 8 + head) * 4096;
#pragma unroll
        for (int tt = 0; tt < 2; ++tt) { const int id = wave + 8 * tt, pt = id >> 2, nt = id & 3; *(f32x4*)(ns + (16 * pt + li) * 64 + 16 * nt + 4 * lg) = Sacc[tt]; } }
}

DI void attn_item(const Params& p, unsigned char* lds, int l, int s, int head, int qb) {
    const Seq sq = seq_of(s);
    bf16_t* KS = (bf16_t*)lds;
    bf16_t* VS = KS + 2 * 64 * 72;
    bf16_t* QF = VS + 2 * 64 * 72;
    const int t = otid(), wave = t >> 6, lane = t & 63, r = lane & 31, h = lane >> 5;
    const bf16_t* proj = (const bf16_t*)(p.ws + WS_PROJ);
    bf16_t* mix = (bf16_t*)(p.ws + WS_UBUF);
    const int Lk = sq.smp ? 4608 : 256, niter = Lk >> 6;
    const bf16_t* kb = (const bf16_t*)(p.ws + WS_KBUF) + (sq.smp ? 0 : PK_OFF) + (size_t)(sq.b * 8 + head) * Lk * 64;
    const bf16_t* vb = (const bf16_t*)(p.ws + WS_VTBUF) + (sq.smp ? 0 : PK_OFF) + (size_t)(sq.b * 8 + head) * 64 * Lk;
    const int qpos = qb * 256 + wave * 32 + r; const size_t qtok = (size_t)(sq.base + qpos);
    bf16_t* qf = QF + (size_t)(wave * 4 * 64 + lane) * 8;
    { const float qs = 0.17677669529663687f * 1.4426950408889634f;
      const float frow = (float)(qpos >> 6), fcol = (float)(qpos & 63);
      const float inv[8] = {1.0f, 0.31622776601683794f, 0.1f, 0.031622776601683794f, 0.01f, 0.0031622776601683794f, 0.001f, 0.00031622776601683794f};
      float cs[8], sn[8];
#pragma unroll
      for (int j = 0; j < 8; ++j) { const float ang = (h ? fcol : frow) * inv[j]; const float rev = ang * 0.15915494309189535f; cs[j] = sq.smp ? __builtin_amdgcn_cosf(rev) : 1.f; sn[j] = sq.smp ? __builtin_amdgcn_sinf(rev) : 0.f; }
#pragma unroll
      for (int c = 0; c < 2; ++c) { float x1[8], x2[8], o1[8], o2[8];
          unpack8(*(const u32x4*)(proj + qtok * INW + C_DQ + head * 64 + c * 32 + 8 * h), x1); unpack8(*(const u32x4*)(proj + qtok * INW + C_DQ + head * 64 + c * 32 + 16 + 8 * h), x2);
#pragma unroll
          for (int j = 0; j < 8; ++j) { o1[j] = (x1[j] * cs[j] - x2[j] * sn[j]) * qs; o2[j] = (x1[j] * sn[j] + x2[j] * cs[j]) * qs; }
          *(u32x4*)(qf + (c * 2 + 0) * 512) = pack8(o1); *(u32x4*)(qf + (c * 2 + 1) * 512) = pack8(o2); } }
    float lam;
    { const float* lp = inp(17) + l * 128; const int j = lane & 31; float s1 = lp[j] * lp[32 + j], s2 = lp[64 + j] * lp[96 + j];
#pragma unroll
      for (int o = 16; o >= 1; o >>= 1) { s1 += __shfl_xor(s1, o); s2 += __shfl_xor(s2, o); }
      const float lam_init = l == 0 ? 0.2f : 0.35550906759096934f; lam = __expf(s1) - __expf(s2) + lam_init; }
    f32x16 O[2][2];
#pragma unroll
    for (int c = 0; c < 2; ++c)
#pragma unroll
        for (int mt = 0; mt < 2; ++mt)
#pragma unroll
            for (int i = 0; i < 16; ++i) O[c][mt][i] = 0.f;
    float mrun[2] = {0.f, 0.f}, lrun[2] = {0.f, 0.f};
    f32x16 nmv[2];
#pragma unroll
    for (int c = 0; c < 2; ++c)
#pragma unroll
        for (int i = 0; i < 16; ++i) nmv[c][i] = 0.f;
    const int srow = t >> 3, sseg = (t & 7) * 8;
    u32x4 kreg = *(const u32x4*)(kb + (size_t)srow * 64 + sseg), vreg = *(const u32x4*)(vb + (size_t)srow * Lk + sseg);
    __syncthreads();
    *(u32x4*)(KS + srow * 72 + sseg) = kreg; *(u32x4*)(VS + srow * 72 + sseg) = vreg;
    for (int it = 0; it < niter; ++it) {
        __syncthreads();
        const bf16_t* Kc = KS + (it & 1) * 64 * 72; const bf16_t* Vc = VS + (it & 1) * 64 * 72;
        if (it + 1 < niter) { kreg = *(const u32x4*)(kb + (size_t)(64 * (it + 1) + srow) * 64 + sseg); vreg = *(const u32x4*)(vb + (size_t)srow * Lk + 64 * (it + 1) + sseg); }
#pragma unroll
        for (int c = 0; c < 2; ++c) {
#pragma unroll
            for (int kt = 0; kt < 2; ++kt) {
                f32x16 S = mma32(ldfrag(Kc, 32 * kt + r, 72, c * 32 + 8 * h), *(const bf16x8*)(qf + (c * 2) * 512), nmv[c]);
                S = mma32(ldfrag(Kc, 32 * kt + r, 72, c * 32 + 16 + 8 * h), *(const bf16x8*)(qf + (c * 2 + 1) * 512), S);
                float mx = fmaxf(S[0], S[1]);
#pragma unroll
                for (int i = 2; i < 16; i += 2) mx = fmaxf(mx, fmaxf(S[i], S[i + 1]));
                mx = fmaxf(mx, __shfl_xor(mx, 32));
                const bool need = (it == 0 && kt == 0) || mx > 8.0f;
                if (__ballot(need) != 0ull) {
                    const float d = need ? mx : 0.f; const float alpha = __builtin_amdgcn_exp2f(-d); mrun[c] += d; lrun[c] *= alpha;
                    { const float nm = -mrun[c];
#pragma unroll
                      for (int i = 0; i < 16; ++i) nmv[c][i] = nm; }
#pragma unroll
                    for (int mt = 0; mt < 2; ++mt)
#pragma unroll
                        for (int i = 0; i < 16; ++i) O[c][mt][i] *= alpha;
#pragma unroll
                    for (int i = 0; i < 16; ++i) S[i] -= d;
                }
                f32x2 rs2 = {0.f, 0.f};
#pragma unroll
                for (int i = 0; i < 16; i += 2) { const float e0 = __builtin_amdgcn_exp2f(S[i]), e1 = __builtin_amdgcn_exp2f(S[i + 1]); S[i] = e0; S[i + 1] = e1; rs2 += (f32x2){e0, e1}; }
                lrun[c] += rs2[0] + rs2[1];
#pragma unroll
                for (int s2 = 0; s2 < 2; ++s2) { u32x4 w; w.x = pk2(S[8 * s2], S[8 * s2 + 1]); w.y = pk2(S[8 * s2 + 2], S[8 * s2 + 3]); w.z = pk2(S[8 * s2 + 4], S[8 * s2 + 5]); w.w = pk2(S[8 * s2 + 6], S[8 * s2 + 7]);
                    const bf16x8 pbv = __builtin_bit_cast(bf16x8, w);
#pragma unroll
                    for (int mt = 0; mt < 2; ++mt) { const bf16_t* vp = Vc + (32 * mt + r) * 72 + 32 * kt + 16 * s2 + 4 * h;
                        const s16x4 lo = *(const s16x4*)vp, hi = *(const s16x4*)(vp + 8);
                        const bf16x8 a = __builtin_shufflevector(lo, hi, 0, 1, 2, 3, 4, 5, 6, 7);
                        O[c][mt] = mma32(a, pbv, O[c][mt]); } }
            }
        }
        if (it + 1 < niter) { bf16_t* Kn = KS + ((it + 1) & 1) * 64 * 72; bf16_t* Vn = VS + ((it + 1) & 1) * 64 * 72; *(u32x4*)(Kn + srow * 72 + sseg) = kreg; *(u32x4*)(Vn + srow * 72 + sseg) = vreg; }
    }
    asm volatile("" ::: "memory");
    { const float l0 = lrun[0] + __shfl_xor(lrun[0], 32), l1 = lrun[1] + __shfl_xor(lrun[1], 32);
      const float i0 = 1.0f / l0, i1 = lam / l1; float ss = 0.f;
#pragma unroll
      for (int mt = 0; mt < 2; ++mt)
#pragma unroll
          for (int i = 0; i < 16; ++i) { const float v = O[0][mt][i] * i0 - O[1][mt][i] * i1; O[0][mt][i] = v; ss += v * v; }
      ss += __shfl_xor(ss, 32);
      const float lam_init = l == 0 ? 0.2f : 0.35550906759096934f;
      const float rstd = rsqrtf(ss * (1.0f / 64.0f) + 1e-6f) * (1.0f - lam_init);
      const float* gn = inp(18) + l * 64;
      bf16_t* orow = mix + qtok * DM + 512 + head * 64;
#pragma unroll
      for (int mt = 0; mt < 2; ++mt)
#pragma unroll
          for (int g4 = 0; g4 < 4; ++g4) { const int dv = 32 * mt + 8 * g4 + 4 * h; const f32x4 gv = *(const f32x4*)(gn + dv);
              u32x2 w; w.x = pk2(O[0][mt][4 * g4] * rstd * gv[0], O[0][mt][4 * g4 + 1] * rstd * gv[1]); w.y = pk2(O[0][mt][4 * g4 + 2] * rstd * gv[2], O[0][mt][4 * g4 + 3] * rstd * gv[3]);
              *(u32x2*)(orow + dv) = w; } }
    __syncthreads();
}

template <bool N0, bool N1>
DI void hy_mloop(const unsigned* gr32, const bf16_t* U, f32x16 (&acc)[2][2], int mlo, int mhi, int r, int h, int b, int L, int sh) {
#pragma unroll 1
    for (int m = mlo; m <= mhi; ++m) {
        bool valid[2]; int uoff[2];
#pragma unroll
        for (int nt = 0; nt < 2; ++nt) { const int acol = 32 * nt + r, asrc = acol - m; valid[nt] = asrc >= 0 && asrc < 64 && (asrc >> sh) == (acol >> sh); uoff[nt] = (b * 64 + (valid[nt] ? asrc : 0)) * 72 + 8 * h; }
        u32x4 bw[2][4];
#pragma unroll
        for (int ks = 0; ks < 4; ++ks) { if (N0) { bw[0][ks] = *(const u32x4*)(U + uoff[0] + 16 * ks); if (!valid[0]) bw[0][ks] = (u32x4){0u, 0u, 0u, 0u}; }
            if (N1) { bw[1][ks] = *(const u32x4*)(U + uoff[1] + 16 * ks); if (!valid[1]) bw[1][ks] = (u32x4){0u, 0u, 0u, 0u}; } }
#pragma unroll
        for (int ks = 0; ks < 4; ++ks) {
            bf16x8 af[2];
#pragma unroll
            for (int mt = 0; mt < 2; ++mt) { const int D = 64 * m + r + 32 * mt - 16 * ks - 8 * h; const int p0 = (L - 1) - D; const int wd = p0 >> 1; const unsigned sft = (unsigned)(p0 & 1) * 16u;
                const unsigned d0 = gr32[wd], d1 = gr32[wd + 1], d2 = gr32[wd + 2], d3 = gr32[wd + 3], d4 = gr32[wd + 4];
                u32x4 w; w.x = __builtin_amdgcn_alignbit(d1, d0, sft); w.y = __builtin_amdgcn_alignbit(d2, d1, sft); w.z = __builtin_amdgcn_alignbit(d3, d2, sft); w.w = __builtin_amdgcn_alignbit(d4, d3, sft);
                af[mt] = __builtin_bit_cast(bf16x8, w); }
            if (N0) { const bf16x8 bf = __builtin_bit_cast(bf16x8, bw[0][ks]); acc[0][0] = mma32(af[0], bf, acc[0][0]); acc[1][0] = mma32(af[1], bf, acc[1][0]); }
            if (N1) { const bf16x8 bf = __builtin_bit_cast(bf16x8, bw[1][ks]); acc[0][1] = mma32(af[0], bf, acc[0][1]); acc[1][1] = mma32(af[1], bf, acc[1][1]); }
        }
    }
}
DI void hy_item(const Params& p, unsigned char* lds, int l, int grp, int ch) {
    bf16_t* U = (bf16_t*)lds;
    bf16_t* GRL = U + 8 * 64 * 72;
    const int t = otid(), wave = t >> 6, lane = t & 63, r = lane & 31, h = lane >> 5;
    const int nb = grp ? 8 : 2, base = grp ? NPT : 0, L = grp ? 4096 : 256, sh = grp ? 6 : 2, MM = grp ? 63 : 3, GRLEN = grp ? 8200 : 520;
    bf16_t* hvt = (bf16_t*)(p.ws + WS_HVT) + (size_t)ch * NTOK + base;
    const bf16_t* hx1 = (const bf16_t*)(p.ws + WS_HVT) + (size_t)(512 + ch) * NTOK + base;
    const bf16_t* GR = (const bf16_t*)(p.ws + WS_GR) + (grp ? 0 : GRP_OFF);
    __syncthreads();
    for (int idx = t; idx < nb * 512; idx += 512) { const int b = idx >> 9, rem = idx & 511, a = rem >> 3, seg = (rem & 7) * 8;
        *(u32x4*)(U + (b * 64 + a) * 72 + seg) = *(const u32x4*)(hvt + b * 4096 + a * 64 + seg); }
    for (int o = 0; o < 2; ++o) { const bf16_t* src = GR + (size_t)(o * 512 + ch) * GRLEN;
        for (int idx = t; idx < GRLEN / 8; idx += 512) *(u32x4*)(GRL + o * 8256 + idx * 8) = *(const u32x4*)(src + idx * 8); }
    __syncthreads();
    if (wave < nb) {
        const int b = wave;
        for (int order = 0; order < 2; ++order) {
            const unsigned* gr32 = (const unsigned*)(GRL + order * 8256);
            const float skip = inp(35)[(l * 2 + order) * 512 + ch];
            f32x16 acc[2][2];
#pragma unroll
            for (int mt = 0; mt < 2; ++mt)
#pragma unroll
                for (int nt = 0; nt < 2; ++nt)
#pragma unroll
                    for (int i = 0; i < 16; ++i) acc[mt][nt][i] = 0.f;
            hy_mloop<true, false>(gr32, U, acc, -MM, (-32 < MM ? -32 : MM), r, h, b, L, sh);
            hy_mloop<true, true>(gr32, U, acc, (-MM > -31 ? -MM : -31), (MM < 31 ? MM : 31), r, h, b, L, sh);
            hy_mloop<false, true>(gr32, U, acc, 32, MM, r, h, b, L, sh);
            asm volatile("" ::: "memory");
#pragma unroll
            for (int mt = 0; mt < 2; ++mt)
#pragma unroll
                for (int nt = 0; nt < 2; ++nt)
#pragma unroll
                    for (int g4 = 0; g4 < 4; ++g4) { const int pi = 32 * mt + 8 * g4 + 4 * h, a = 32 * nt + r; bf16_t* up = U + (b * 64 + a) * 72 + pi; const size_t gofs = (size_t)b * 4096 + a * 64 + pi;
                        const u32x2 uw = *(const u32x2*)up; float y[4];
                        y[0] = acc[mt][nt][4 * g4] + skip * lo16(uw.x); y[1] = acc[mt][nt][4 * g4 + 1] + skip * hi16(uw.x); y[2] = acc[mt][nt][4 * g4 + 2] + skip * lo16(uw.y); y[3] = acc[mt][nt][4 * g4 + 3] + skip * hi16(uw.y);
                        if (order == 0) { const u32x2 xw = *(const u32x2*)(hx1 + gofs); y[0] *= lo16(xw.x); y[1] *= hi16(xw.x); y[2] *= lo16(xw.y); y[3] *= hi16(xw.y);
                            u32x2 w; w.x = pk2(y[0], y[1]); w.y = pk2(y[2], y[3]); *(u32x2*)up = w; }
                        else { u32x2 w; w.x = pk2(y[0], y[1]); w.y = pk2(y[2], y[3]); *(u32x2*)(hvt + gofs) = w; } }
        }
    }
}

DI void m3_item(const Params& p, unsigned char* lds, int l, int tile, const int half) {
    bf16_t* T = (bf16_t*)lds;
    const int t = otid(), i = t >> 3, seg = (t & 7) * 8;
    const int tok0 = tile * 64, tok = tok0 + i;
    int pos, L; if (tok < NPT) { pos = tok & 255; L = 256; } else { pos = (tok - NPT) & 4095; L = 4096; }
    const bf16_t* proj = (const bf16_t*)(p.ws + WS_PROJ);
    bf16_t* mix = (bf16_t*)(p.ws + WS_UBUF);
    const bf16_t* ot = (const bf16_t*)(p.ws + WS_HVT);
    if (half == 0) {
    {
        const bf16_t* glaf = (const bf16_t*)(p.ws + WS_GLAF) + (size_t)tok * 512; bf16_t* row = mix + (size_t)tok * DM; const bf16_t* pr = proj + (size_t)tok * INW;
        const float* gn = inp(16) + l * 64 + seg;
        float gnv[8];
#pragma unroll
        for (int j = 0; j < 8; ++j) gnv[j] = gn[j];
#pragma unroll 2
        for (int q = 0; q < 8; ++q) { float a[8], b[8], gg[8]; unpack8(*(const u32x4*)(glaf + q * 64 + seg), a); unpack8(*(const u32x4*)(row + q * 64 + seg), b); unpack8(*(const u32x4*)(pr + C_GG + q * 64 + seg), gg);
            float ss = 0.f;
#pragma unroll
            for (int j = 0; j < 8; ++j) { a[j] += b[j]; ss += a[j] * a[j]; }
            ss += __shfl_xor(ss, 1); ss += __shfl_xor(ss, 2); ss += __shfl_xor(ss, 4);
            const float rstd = rsqrtf(ss * (1.0f / 64.0f) + 1e-6f);
#pragma unroll
            for (int j = 0; j < 8; ++j) a[j] = a[j] * rstd * gnv[j] * siluf(gg[j]);
            *(u32x4*)(row + q * 64 + seg) = pack8(a); }
    }
    {
        const bf16_t* ssdf = (const bf16_t*)(p.ws + WS_SSDF) + (size_t)tok * 512; bf16_t* row = mix + (size_t)tok * DM + 1024; const bf16_t* pr = proj + (size_t)tok * INW;
        float ss = 0.f;
#pragma unroll 2
        for (int q = 0; q < 8; ++q) { float a[8], b[8], zz[8]; unpack8(*(const u32x4*)(ssdf + q * 64 + seg), a); unpack8(*(const u32x4*)(row + q * 64 + seg), b); unpack8(*(const u32x4*)(pr + C_SZ + q * 64 + seg), zz);
#pragma unroll
            for (int j = 0; j < 8; ++j) { const float y = (a[j] + b[j]) * siluf(zz[j]); a[j] = y; ss += y * y; }
            *(u32x4*)(row + q * 64 + seg) = pack8(a); }
        ss += __shfl_xor(ss, 1); ss += __shfl_xor(ss, 2); ss += __shfl_xor(ss, 4);
        const float rstd = rsqrtf(ss * (1.0f / 512.0f) + 1e-6f); const float* g = inp(24) + l * 512;
#pragma unroll 4
        for (int q = 0; q < 8; ++q) { float a[8]; unpack8(*(const u32x4*)(row + q * 64 + seg), a);
#pragma unroll
            for (int j = 0; j < 8; ++j) a[j] *= rstd * g[q * 64 + seg + j];
            *(u32x4*)(row + q * 64 + seg) = pack8(a); }
    }
    return; }
    const float* cw = inp(25) + (size_t)l * 3 * 1536 + 1024; const float* cb = inp(26) + l * 1536 + 1024;
    for (int cgp = 0; cgp < 8; ++cgp) {
        __syncthreads();
        *(u32x4*)(T + i * 72 + seg) = *(const u32x4*)(ot + (size_t)(cgp * 64 + i) * NTOK + tok0 + seg);
        __syncthreads();
        float x2[8]; conv3x8(proj, tok, pos, L, C_HY + 1024 + cgp * 64 + seg, cw + cgp * 64 + seg, 1536, cb + cgp * 64 + seg, x2);
#pragma unroll
        for (int j = 0; j < 8; ++j) x2[j] *= bf2f(T[(seg + j) * 72 + i]);
        *(u32x4*)(mix + (size_t)tok * DM + 1536 + cgp * 64 + seg) = pack8(x2);
    }
}

#ifndef PHM
#define PHM 0xFFFF
#endif
#define ON(k) ((PHM >> (k)) & 1)
constexpr int M2_ITEMS = 3584;
DI void m2_dispatch(const Params& p, unsigned char* lds, int l, int it) {
    if (it < 128) { if (ON(8)) ssd_item(p, lds, l, 32 + (it >> 4), (it >> 1) & 7, it & 1); }
    else if (it < 256) { it -= 128; if (ON(9)) gla_item(p, lds, l, 32 + (it >> 4), (it >> 1) & 7, it & 1); }
    else if (it < 1280) { it -= 256; if (ON(10)) attn_item(p, lds, l, 32 + (it >> 7), (it >> 4) & 7, it & 15); }
    else if (it < 1792) { it -= 1280; if (ON(11)) hy_item(p, lds, l, 1, it); }
    else if (it < 2304) { it -= 1792; if (ON(8)) ssd_item(p, lds, l, it >> 4, (it >> 1) & 7, it & 1); }
    else if (it < 2816) { it -= 2304; if (ON(9)) gla_item(p, lds, l, it >> 4, (it >> 1) & 7, it & 1); }
    else if (it < 3072) { it -= 2816; if (ON(10)) attn_item(p, lds, l, it >> 3, it & 7, 0); }
    else { it -= 3072; if (ON(11)) hy_item(p, lds, l, 0, it); }
}

DI void load_params(Params& q) { kargp_t ka = (kargp_t)__builtin_amdgcn_kernarg_segment_ptr(); q.out = (float*)ka[39]; q.ws = (unsigned char*)ka[40]; }
DI void gsync(unsigned* ctr, unsigned& target) {
    asm volatile("s_waitcnt vmcnt(0)" ::: "memory");
    __syncthreads();
    if (threadIdx.x == 0) {
        target += gridDim.x;
        __builtin_amdgcn_fence(__ATOMIC_RELEASE, "agent");
        asm volatile("s_waitcnt vmcnt(0)" ::: "memory");
        __hip_atomic_fetch_add(ctr, 1u, __ATOMIC_RELAXED, __HIP_MEMORY_SCOPE_AGENT);
        while (__hip_atomic_load(ctr, __ATOMIC_RELAXED, __HIP_MEMORY_SCOPE_AGENT) < target) __builtin_amdgcn_s_sleep(1);
        __builtin_amdgcn_fence(__ATOMIC_ACQUIRE, "agent");
        asm volatile("s_waitcnt vmcnt(0)" ::: "memory");
    }
    __syncthreads();
}
#define PHASE_BEGIN int G = gridDim.x, bx = blockIdx.x; asm volatile("" : "+s"(G), "+s"(bx)); Params p; load_params(p); float* mods = (float*)(p.ws + WS_CTL + CTL_MODS); (void)mods; (void)G; (void)bx;
DI void run_layer(unsigned* gctr, unsigned& gtarget, unsigned char* lds, const int l) {
    {
        PHASE_BEGIN
        if (ON(2)) ph_norm(p, l, 0);
        if (G == 256) {
            if (ON(1)) filter_item(p, lds, l, bx, 1);
            if (bx < 16) { if (ON(1)) filter_item(p, lds, l, 256 + bx, 1); if (ON(3)) { wconv_item(p, lds, l, bx); wconv_item(p, lds, l, bx + 16); } }
            else { for (int w = 32 + (bx - 16); w < 3072; w += 240) { if (ON(3)) wconv_item(p, lds, l, w); } }
        } else {
            for (int it = bx; it < 3072 + 272; it += G) { if (it < 3072) { if (ON(3)) wconv_item(p, lds, l, it); } else { if (ON(1)) filter_item(p, lds, l, it - 3072, 1); } }
        }
    }
    gsync(gctr, gtarget);
    {
        PHASE_BEGIN
        pg8::Gemm g{(const bf16_t*)(p.ws + WS_UBUF), (const bf16_t*)(p.ws + WS_WIN), NTOK, INWP, DM}; pg8::StaticOrder S; S.init(NTOK, INWP, G, bx);
        pg8::EpiBf16 E{(bf16_t*)(p.ws + WS_PROJ), INW, INW, 0};
        if (ON(4)) pg8::gemm_phase<pg8::EpiBf16>((LAS unsigned char*)lds, g, S, E);
    }
    gsync(gctr, gtarget);
    {
        PHASE_BEGIN
        for (int it = bx; it < 640 + 640 + 640 + 64; it += G) { if (it < 640) { if (ON(7)) kvprep_item(p, lds, l, it); } else if (it < 1280) { if (ON(12)) hyprep_item(p, lds, l, it - 640); } else if (it < 1920) { if (ON(12)) xbcprep_item(p, lds, l, it - 1280); } else { if (ON(13)) ctxprep_item(p, lds, l, it - 1920); } }
    }
    gsync(gctr, gtarget);
    {
        PHASE_BEGIN
        unsigned* q = (unsigned*)(p.ws + WS_CTL + CTL_Q) + l * 16;
        volatile int* slot = (volatile int*)(lds + LDS_MISC);
        int nxt = 0;
        if (threadIdx.x == 0) nxt = (int)atomicAdd(q, 1u);
        for (;;) {
            __syncthreads();
            if (threadIdx.x == 0) *slot = nxt;
            __syncthreads();
            const int it = *slot;
            if (it >= M2_ITEMS) break;
            if (threadIdx.x == 0) nxt = (int)atomicAdd(q, 1u);
            Params pi; load_params(pi);
            m2_dispatch(pi, lds, l, it);
        }
    }
    gsync(gctr, gtarget);
    {
        PHASE_BEGIN
        for (int it = bx; it < 1280; it += G) { if (ON(14)) { if (it < 640) m3_item(p, lds, l, it, 0); else m3_item(p, lds, l, it - 640, 1); } }
    }
    gsync(gctr, gtarget);
    {
        PHASE_BEGIN
        pg8::Gemm g{(const bf16_t*)(p.ws + WS_UBUF), (const bf16_t*)(p.ws + WS_WOUT), NTOK, DM, DM}; pg8::StaticOrder S; S.init(NTOK, DM, G, bx);
        pg8::EpiRes E{l == 0 ? inp(0) : p.out, l == 0 ? inp(1) : p.out + (size_t)NPT * DM, p.out, mods + (size_t)l * 9 * 12288 + 2 * DM};
        if (ON(6)) pg8::gemm_phase<pg8::EpiRes>((LAS unsigned char*)lds, g, S, E);
    }
    gsync(gctr, gtarget);
    {
        PHASE_BEGIN
        if (ON(2)) ph_norm(p, l, 1);
    }
    gsync(gctr, gtarget);
    {
        PHASE_BEGIN
        pg8::Gemm g{(const bf16_t*)(p.ws + WS_UBUF), (const bf16_t*)(p.ws + WS_W1), NTOK, DFF, DM}; pg8::StaticOrder S; S.init(NTOK, DFF, G, bx);
        pg8::EpiBf16 E{(bf16_t*)(p.ws + WS_PROJ), DFF, DFF, 1};
        if (ON(4)) pg8::gemm_phase<pg8::EpiBf16>((LAS unsigned char*)lds, g, S, E);
    }
    gsync(gctr, gtarget);
    {
        PHASE_BEGIN
        pg8::Gemm g{(const bf16_t*)(p.ws + WS_PROJ), (const bf16_t*)(p.ws + WS_W2), NTOK, DM, DFF}; pg8::StaticOrder S; S.init(NTOK, DM, G, bx);
        pg8::EpiRes E{p.out, p.out + (size_t)NPT * DM, p.out, mods + (size_t)l * 9 * 12288 + 5 * DM};
        if (ON(6)) pg8::gemm_phase<pg8::EpiRes>((LAS unsigned char*)lds, g, S, E);
    }
    gsync(gctr, gtarget);
}
__global__ void __launch_bounds__(512, 2) mega(KArgs p_unused) {
    extern __shared__ __attribute__((aligned(16))) unsigned char lds[];
    cg::grid_group grid = cg::this_grid();
    {
        PHASE_BEGIN
        for (int it = bx; it < 192 + 544; it += G) { if (it < 192) { if (ON(0)) ada_item(p, lds, it); } else { const int f = it - 192; if (ON(1)) filter_item(p, lds, f / 272, f % 272, 0); } }
    }
    grid.sync();
    unsigned gtarget = 0; unsigned* gctr;
    { Params pq; load_params(pq); gctr = (unsigned*)(pq.ws + WS_CTL + CTL_Q) + 32; }
    run_layer(gctr, gtarget, lds, 0);
    run_layer(gctr, gtarget, lds, 1);
    {
        PHASE_BEGIN
        if (ON(2)) ph_norm(p, 0, 2);
    }
}

extern "C" void kernel_launch(void* const* d_in, const int* in_sizes, int n_in, void* d_out, int out_size, void* d_ws, size_t ws_size, hipStream_t stream) {
    static int grid = 0;
    if (grid == 0) {
        if (n_in != 39 || ws_size < WS_END) { fprintf(stderr, "kernel_launch: unexpected n_in %d or ws_size %zu (need %zu)\n", n_in, ws_size, (size_t)WS_END); grid = -1; return; }
        if (hipFuncSetAttribute((const void*)mega, hipFuncAttributeMaxDynamicSharedMemorySize, LDS_BYTES) != hipSuccess) { fprintf(stderr, "kernel_launch: hipFuncSetAttribute failed\n"); grid = -1; return; }
        int dev = 0, cus = 0, per_cu = 0;
        hipGetDevice(&dev); hipDeviceGetAttribute(&cus, hipDeviceAttributeMultiprocessorCount, dev);
        hipOccupancyMaxActiveBlocksPerMultiprocessor(&per_cu, (const void*)mega, 512, LDS_BYTES);
        if (per_cu < 1) { fprintf(stderr, "kernel_launch: occupancy query says %d blocks/CU\n", per_cu); per_cu = 1; }
        grid = cus * 1;
        (void)hipGetLastError();
    }
    if (grid < 0) return;
    hipMemsetAsync((char*)d_ws + WS_CTL, 0, CTL_BYTES, stream);
    KArgs p{};
    for (int i = 0; i < 39; ++i) p.in[i] = (const float*)d_in[i];
    p.out = (float*)d_out; p.ws = (unsigned char*)d_ws; p.ph_lo = 0; p.ph_hi = NPHASE;
    void* args[] = {&p};
    hipError_t e = hipLaunchCooperativeKernel((const void*)mega, dim3(grid), dim3(512), args, LDS_BYTES, stream);
    if (e != hipSuccess) fprintf(stderr, "cooperative launch failed: %s (grid %d)\n", hipGetErrorString(e), grid);
}
```

```cpp
#include <hip/hip_runtime.h>
#include <hip/hip_cooperative_groups.h>
#include <cstdio>
namespace cg = cooperative_groups;

#define DI __device__ __forceinline__
#define LAS __attribute__((address_space(3)))
typedef unsigned short bf16_t;
typedef short bf16x8 __attribute__((ext_vector_type(8)));
typedef short s16x4 __attribute__((ext_vector_type(4)));
typedef float f32x4 __attribute__((ext_vector_type(4)));
typedef float f32x16 __attribute__((ext_vector_type(16)));
typedef unsigned u32x4 __attribute__((ext_vector_type(4)));
typedef unsigned u32x2 __attribute__((ext_vector_type(2)));

constexpr int NTOK = 40960, NPT = 8192, DM = 2048, INW = 5936, INWP = 6144, DFF = 8192;
constexpr int C_GQ = 0, C_GK = 256, C_GV = 512, C_GG = 1024, C_GR = 1536, C_DQ = 1568, C_DK = 2080, C_DV = 2592, C_SZ = 3104, C_SX = 3616, C_SDT = 4384, C_HY = 4400;
constexpr size_t O_NK = 83886080, O_NV = 92274688, O_NG = 100663296, O_NS = 102760448;
constexpr size_t WS_PROJ = 0;
constexpr size_t WS_HVT = 486277120;
constexpr size_t WS_GLAF = WS_HVT + 83886080;
constexpr size_t WS_SSDF = WS_GLAF + 41943040;
constexpr size_t WS_UBUF = 671088640;
constexpr size_t WS_WIN = 838860800, WS_WOUT = WS_WIN + 25165824, WS_W1 = WS_WOUT + 8388608, WS_W2 = WS_W1 + 33554432;
constexpr size_t WS_KBUF = 939524096;
constexpr size_t WS_VTBUF = WS_KBUF + 46137344;
constexpr size_t WS_GR = WS_VTBUF + 46137344;
constexpr size_t WS_CTL = WS_GR + 17858560;
constexpr size_t CTL_MODS = 0, CTL_HYSUM = 884736, CTL_Q = CTL_HYSUM + 16384, CTL_BYTES = CTL_Q + 256;
constexpr size_t WS_BC = WS_CTL + CTL_BYTES;
constexpr size_t WS_END = WS_BC + 20971520;
constexpr size_t PK_OFF = 18874368;
constexpr size_t GRP_OFF = 8396800;
constexpr int LDS_MISC = 131072, LDS_BYTES = 131072 + 256;
constexpr int NPHASE = 20;

struct KArgs { const float* in[39]; float* out; unsigned char* ws; int ph_lo, ph_hi; };
struct Params { float* out; unsigned char* ws; };
typedef const volatile unsigned long long __attribute__((address_space(4)))* kargp_t;
__device__ __forceinline__ const float* inp(int k) { kargp_t ka = (kargp_t)__builtin_amdgcn_kernarg_segment_ptr(); return (const float*)ka[k]; }

DI float bf2f(bf16_t v) { return __uint_as_float(((unsigned)v) << 16); }
typedef float f32x2 __attribute__((ext_vector_type(2)));
typedef __bf16 hbf16x2 __attribute__((ext_vector_type(2)));
DI unsigned pk2(float lo, float hi) { f32x2 v = {lo, hi}; hbf16x2 b = __builtin_convertvector(v, hbf16x2); return __builtin_bit_cast(unsigned, b); }
DI bf16_t f2bf(float f) { return (bf16_t)(pk2(f, 0.f) & 0xffffu); }
DI float lo16(unsigned w) { return __uint_as_float(w << 16); }
DI float hi16(unsigned w) { return __uint_as_float(w & 0xffff0000u); }
DI float siluf(float x) { return x / (1.f + __expf(-x)); }
DI float sinr(float x) { return __builtin_amdgcn_sinf(x * 0.15915494309189535f); }
DI void unpack8(u32x4 w, float* v) { v[0] = lo16(w.x); v[1] = hi16(w.x); v[2] = lo16(w.y); v[3] = hi16(w.y); v[4] = lo16(w.z); v[5] = hi16(w.z); v[6] = lo16(w.w); v[7] = hi16(w.w); }
DI u32x4 pack8(const float* v) { u32x4 w; w.x = pk2(v[0], v[1]); w.y = pk2(v[2], v[3]); w.z = pk2(v[4], v[5]); w.w = pk2(v[6], v[7]); return w; }
DI f32x4 mma16(bf16x8 a, bf16x8 b, f32x4 c) { return __builtin_amdgcn_mfma_f32_16x16x32_bf16(a, b, c, 0, 0, 0); }
DI f32x16 mma32(bf16x8 a, bf16x8 b, f32x16 c) { return __builtin_amdgcn_mfma_f32_32x32x16_bf16(a, b, c, 0, 0, 0); }
DI bf16x8 ldfrag(const bf16_t* base, int row, int stride, int koff) { return *(const bf16x8*)(base + row * stride + koff); }

DI int otid() { int t = threadIdx.x; asm volatile("" : "+v"(t)); return t; }
struct Seq { int base, L, modrow, smp, b; };
DI Seq seq_of(int s) { Seq q; if (s < 32) { q.base = 256 * s; q.L = 256; q.modrow = 0; q.smp = 0; q.b = s; } else { q.b = s - 32; q.base = NPT + 4096 * q.b; q.L = 4096; q.modrow = 1 + q.b; q.smp = 1; } return q; }

namespace pg8 {
constexpr int BM = 256, BK = 64, HALF = 128, HTB = HALF * BK * 2, STAGE_BYTES = 8 * HTB, NXCD = 8, WGM = 8;
DI int lds_byte(int r, int c) { const int st = (r >> 4) * 2 + (c >> 5), rr = r & 15, cc = c & 31, ob = rr * 64 + cc * 2; return st * 1024 + (ob ^ (((ob >> 9) & 1) << 5)); }
DI void stage_rc(int b, int& R, int& C) { const int st = b / 1024, sb = b % 1024, swz = sb ^ (((sb >> 9) & 1) << 5); R = (st >> 1) * 16 + swz / 64; C = (st & 1) * 32 + (swz % 64) / 2; }
DI int perm32(int rho) { const int n = rho >> 4, i = rho & 15; return 8 * (i >> 2) + 4 * n + (i & 3); }
struct Unit { int pm, pn; };
struct Gemm { const bf16_t* A; const bf16_t* Bt; int M, N, K; };
struct StaticOrder {
    int nM, nN, nwg, G, c;
    DI void init(int M, int N, int G_, int c_) { nM = M / BM; nN = N / BM; nwg = nM * nN; G = G_; c = c_; }
    DI bool next(int i, Unit& u) const {
        const long L = (long)i * G + c; if (L >= nwg) return false;
        int wgid = (int)L; { const int q = nwg / NXCD, r = nwg % NXCD, xcd = wgid % NXCD, off = wgid / NXCD; wgid = (xcd < r ? xcd * (q + 1) : r * (q + 1) + (xcd - r) * q) + off; }
        const int nig = WGM * nN, gid = wgid / nig, fm = gid * WGM, gsz = (nM - fm) < WGM ? (nM - fm) : WGM;
        u.pm = fm + ((wgid % nig) % gsz); u.pn = (wgid % nig) / gsz; return true;
    }
};
DI unsigned cvt_pk_bf16(float lo, float hi) { unsigned r; asm volatile("v_cvt_pk_bf16_f32 %0, %1, %2" : "=v"(r) : "v"(lo), "v"(hi)); return r; }

struct EpiBf16 {
    static constexpr bool PERM = true;
    bf16_t* O; int ldc; int ncols; int act;
    DI void operator()(const f32x4 (&acc)[2][2][4][2], const Unit& u, int wr, int wc, int fr, int fq) const {
        int row0 = u.pm * BM + wr * 64 + fr; asm volatile("" : "+v"(row0)); const int col0 = u.pn * BM + wc * 32 + 8 * fq;
#pragma unroll
        for (int ai = 0; ai < 2; ++ai)
#pragma unroll
            for (int m = 0; m < 4; ++m) { bf16_t* rowp = O + (size_t)(row0 + ai * HALF + m * 16) * ldc + col0;
#pragma unroll
                for (int bj = 0; bj < 2; ++bj) { f32x4 v0 = acc[ai][bj][m][0], v1 = acc[ai][bj][m][1];
                    if (act == 1) {
#pragma unroll
                        for (int j = 0; j < 4; ++j) { const float a = fmaxf(v0[j], 0.f), b = fmaxf(v1[j], 0.f); v0[j] = a * a; v1[j] = b * b; } }
                    u32x4 w; w.x = cvt_pk_bf16(v0[0], v0[1]); w.y = cvt_pk_bf16(v0[2], v0[3]); w.z = cvt_pk_bf16(v1[0], v1[1]); w.w = cvt_pk_bf16(v1[2], v1[3]);
                    if (col0 + bj * HALF < ncols) *(u32x4*)(rowp + bj * HALF) = w; } }
    }
};
struct EpiRes {
    static constexpr bool PERM = false;
    const float* xin_p; const float* xin_s; float* out; const float* gate_l;
    DI void operator()(const f32x4 (&acc)[2][2][4][2], const Unit& u, int wr, int wc, int fr, int fq) const {
        const int tok0 = u.pm * BM; const int modrow = tok0 < NPT ? 0 : 1 + ((tok0 - NPT) >> 12);
        const float* xin = tok0 < NPT ? xin_p + (size_t)tok0 * DM : xin_s + (size_t)(tok0 - NPT) * DM;
        int rl0 = wr * 64 + fr; asm volatile("" : "+v"(rl0)); const int col0 = u.pn * BM + wc * 32 + 4 * fq;
        const float* gp = gate_l + (size_t)modrow * 12288 + col0;
        asm volatile("" ::: "memory");
        f32x4 gv[2][2];
#pragma unroll
        for (int bj = 0; bj < 2; ++bj)
#pragma unroll
            for (int n = 0; n < 2; ++n) gv[bj][n] = *(const f32x4*)(gp + bj * HALF + n * 16);
#pragma unroll
        for (int ai = 0; ai < 2; ++ai)
#pragma unroll
            for (int m = 0; m < 4; ++m) { const int rl = rl0 + ai * HALF + m * 16; const float* xr = xin + (size_t)rl * DM + col0; float* orow = out + (size_t)(tok0 + rl) * DM + col0;
#pragma unroll
                for (int bj = 0; bj < 2; ++bj)
#pragma unroll
                    for (int n = 0; n < 2; ++n) { const f32x4 xv = *(const f32x4*)(xr + bj * HALF + n * 16); *(f32x4*)(orow + bj * HALF + n * 16) = xv + gv[bj][n] * acc[ai][bj][m][n]; }
                if (m & 1) asm volatile("" ::: "memory"); }
    }
};

template <class Epi>
DI void gemm_phase(LAS unsigned char* lds, const Gemm g, const StaticOrder& S, const Epi& E) {
    const int tid = otid(), wid = __builtin_amdgcn_readfirstlane(tid >> 6), lane = tid & 63, wr = wid >> 2, wc = wid & 3, fr = lane & 15, fq = lane >> 4;
    const int K = g.K, nt = K / BK;
    unsigned voffA[2], voffB[2];
#pragma unroll
    for (int i = 0; i < 2; ++i) { int R, C; stage_rc(tid * 16 + i * 8192, R, C); const int Rb = Epi::PERM ? ((R & ~31) + perm32(R & 31)) : R;
        voffA[i] = (unsigned)(R * K + C) * 2u; voffB[i] = (unsigned)(Rb * K + C) * 2u; }
    const size_t kstep = (size_t)(BK * 2);
    const size_t hstep = (size_t)HALF * K * 2;
    const size_t tstep = 2 * hstep;
    const unsigned ldsw = (unsigned)wid * 1024u;
    const int aoff = lds_byte(wr * 64 + fr, fq * 8), boff = lds_byte(wc * 32 + fr, fq * 8);
#define PG8_SA(b, h) (((b) * 2 + (h)) * HTB)
#define PG8_SB(b, h) ((4 + (b) * 2 + (h)) * HTB)
#define PG8_STAGE(bufoff, gbase, voff) do { _Pragma("unroll") for (int _i = 0; _i < 2; ++_i) \
        __builtin_amdgcn_global_load_lds((const unsigned*)((const char*)(gbase) + (voff)[_i]), (LAS unsigned*)(lds + (bufoff) + ldsw + _i * 8192), 16, 0, 0); } while (0)
#define PG8_LDA(dst, b, h) do { _Pragma("unroll") for (int m = 0; m < 4; ++m) _Pragma("unroll") for (int k = 0; k < 2; ++k) dst[m][k] = *(const LAS bf16x8*)(lds + PG8_SA(b, h) + aoff + m * 2048 + k * 1024); } while (0)
#define PG8_LDB(dst, b, h) do { _Pragma("unroll") for (int n = 0; n < 2; ++n) _Pragma("unroll") for (int k = 0; k < 2; ++k) dst[n][k] = *(const LAS bf16x8*)(lds + PG8_SB(b, h) + boff + n * 2048 + k * 1024); } while (0)
#define PG8_MMA(ai, bj, At, Bt) do { __builtin_amdgcn_s_setprio(1); _Pragma("unroll") for (int m = 0; m < 4; ++m) _Pragma("unroll") for (int n = 0; n < 2; ++n) _Pragma("unroll") for (int k = 0; k < 2; ++k) \
        acc[ai][bj][m][n] = __builtin_amdgcn_mfma_f32_16x16x32_bf16(Bt[n][k], At[m][k], acc[ai][bj][m][n], 0, 0, 0); __builtin_amdgcn_s_setprio(0); } while (0)
#define PG8_WAIT_V(n) asm volatile("s_waitcnt vmcnt(" #n ")" ::: "memory")
#define PG8_WAIT_L(n) asm volatile("s_waitcnt lgkmcnt(" #n ")" ::: "memory")
#define PG8_BAR __builtin_amdgcn_s_barrier()
#define PG8_SCHED __builtin_amdgcn_sched_barrier(0)
    Unit cur, nxt; int ui = 0;
    if (!S.next(0, cur)) return;
    f32x4 acc[2][2][4][2];
#pragma unroll
    for (int a = 0; a < 2; ++a)
#pragma unroll
        for (int b = 0; b < 2; ++b)
#pragma unroll
            for (int m = 0; m < 4; ++m)
#pragma unroll
                for (int n = 0; n < 2; ++n) acc[a][b][m][n] = (f32x4){0.f, 0.f, 0.f, 0.f};
    bf16x8 At[4][2], B0[2][2], B1[2][2];
    const char* cA = (const char*)g.A + (size_t)cur.pm * tstep; const char* cB = (const char*)g.Bt + (size_t)cur.pn * tstep;
    PG8_STAGE(PG8_SB(0, 0), cB, voffB); PG8_STAGE(PG8_SA(0, 0), cA, voffA); PG8_STAGE(PG8_SB(0, 1), cB + hstep, voffB); PG8_STAGE(PG8_SA(0, 1), cA + hstep, voffA);
    if (wr == 1) PG8_BAR;
    PG8_WAIT_V(4); PG8_BAR;
    PG8_STAGE(PG8_SB(1, 0), cB + kstep, voffB); PG8_STAGE(PG8_SA(1, 0), cA + kstep, voffA); PG8_STAGE(PG8_SB(1, 1), cB + hstep + kstep, voffB);
    PG8_WAIT_V(6); PG8_BAR;
    for (;;) {
        const bool has_next = S.next(ui + 1, nxt);
        const char* nA = has_next ? (const char*)g.A + (size_t)nxt.pm * tstep : cA; const char* nB = has_next ? (const char*)g.Bt + (size_t)nxt.pn * tstep : cB;
        for (int t = 0; t < nt; t += 2) {
            const bool last = (t == nt - 2);
            const char* a1 = cA + (size_t)(t + 1) * kstep;
            const char* a2 = last ? nA : cA + (size_t)(t + 2) * kstep; const char* b2 = last ? nB : cB + (size_t)(t + 2) * kstep;
            const char* a3 = a2 + kstep; const char* b3 = b2 + kstep;
            PG8_LDB(B0, 0, 0); PG8_SCHED; PG8_LDA(At, 0, 0); PG8_STAGE(PG8_SA(1, 1), a1 + hstep, voffA);
            PG8_WAIT_L(8); PG8_BAR; PG8_WAIT_L(0); PG8_MMA(0, 0, At, B0); PG8_BAR; PG8_SCHED;
            PG8_LDB(B1, 0, 1); PG8_STAGE(PG8_SB(0, 0), b2, voffB);
            PG8_BAR; PG8_WAIT_L(0); PG8_MMA(0, 1, At, B1); PG8_BAR;
            PG8_LDA(At, 0, 1); PG8_STAGE(PG8_SA(0, 0), a2, voffA);
            PG8_BAR; PG8_WAIT_L(0); PG8_MMA(1, 0, At, B0); PG8_BAR; PG8_SCHED;
            PG8_STAGE(PG8_SB(0, 1), b2 + hstep, voffB);
            PG8_WAIT_V(6); PG8_BAR; PG8_MMA(1, 1, At, B1); PG8_BAR;
            PG8_LDB(B0, 1, 0); PG8_SCHED; PG8_LDA(At, 1, 0); PG8_STAGE(PG8_SA(0, 1), a2 + hstep, voffA);
            PG8_WAIT_L(8); PG8_BAR; PG8_WAIT_L(0); PG8_MMA(0, 0, At, B0); PG8_BAR; PG8_SCHED;
            PG8_LDB(B1, 1, 1); PG8_STAGE(PG8_SB(1, 0), b3, voffB);
            PG8_BAR; PG8_WAIT_L(0); PG8_MMA(0, 1, At, B1); PG8_BAR;
            PG8_LDA(At, 1, 1); PG8_STAGE(PG8_SA(1, 0), a3, voffA);
            PG8_BAR; PG8_WAIT_L(0); PG8_MMA(1, 0, At, B0); PG8_BAR; PG8_SCHED;
            PG8_STAGE(PG8_SB(1, 1), b3 + hstep, voffB);
            PG8_WAIT_V(6); PG8_BAR; PG8_MMA(1, 1, At, B1); PG8_BAR;
        }
        E(acc, cur, wr, wc, fr, fq);
        if (!has_next) break;
#pragma unroll
        for (int a = 0; a < 2; ++a)
#pragma unroll
            for (int b = 0; b < 2; ++b)
#pragma unroll
                for (int m = 0; m < 4; ++m)
#pragma unroll
                    for (int n = 0; n < 2; ++n) acc[a][b][m][n] = (f32x4){0.f, 0.f, 0.f, 0.f};
        cur = nxt; cA = nA; cB = nB; ++ui;
    }
    PG8_WAIT_V(0);
    if (wr == 0) PG8_BAR;
    PG8_BAR;
#undef PG8_SA
#undef PG8_SB
#undef PG8_STAGE
#undef PG8_LDA
#undef PG8_LDB
#undef PG8_MMA
#undef PG8_WAIT_V
#undef PG8_WAIT_L
#undef PG8_BAR
#undef PG8_SCHED
}
}


DI void ada_item(const Params& p, unsigned char* lds, int it) {
    float* sil = (float*)lds;
    const int t = otid();
    const int l = it / 96, r = it % 96, kc = r / 12, nc = r % 12;
    __syncthreads();
    for (int e = t; e < 9 * 256; e += 512) { const int rr = e >> 8, k = kc * 256 + (e & 255); const float c = rr == 0 ? inp(7)[k] : inp(6)[(rr - 1) * 2048 + k]; sil[e] = siluf(c); }
    __syncthreads();
    const int n = nc * 1024 + t * 2;
    const float* w = inp(8) + ((size_t)l * 2048 + kc * 256) * 12288 + n;
    float a0[9], a1[9];
#pragma unroll
    for (int rr = 0; rr < 9; ++rr) { a0[rr] = 0.f; a1[rr] = 0.f; }
#pragma unroll 16
    for (int k = 0; k < 256; ++k) { const float2 wv = *(const float2*)(w + (size_t)k * 12288);
#pragma unroll
        for (int rr = 0; rr < 9; ++rr) { const float s = sil[rr * 256 + k]; a0[rr] += s * wv.x; a1[rr] += s * wv.y; } }
    float* mods = (float*)(p.ws + WS_CTL + CTL_MODS) + (size_t)l * 9 * 12288;
    const float b0 = kc == 0 ? inp(9)[l * 12288 + n] : 0.f, b1 = kc == 0 ? inp(9)[l * 12288 + n + 1] : 0.f;
#pragma unroll
    for (int rr = 0; rr < 9; ++rr) { atomicAdd(&mods[rr * 12288 + n], a0[rr] + b0); atomicAdd(&mods[rr * 12288 + n + 1], a1[rr] + b1); }
}

DI void filter_tile(const Params& p, unsigned char* lds, int l, int grp, int pos0, int mode) {
    const int L = grp ? 4096 : 256;
    float* z = (float*)lds;
    float* h1 = z + 16 * 33;
    float* h2 = h1 + 16 * 64;
    const int t = otid();
    const float invL = 1.0f / (float)L;
    __syncthreads();
    for (int e = t; e < 16 * 33; e += 512) {
        const int ps = e / 33, k = e % 33, pp = pos0 + ps; float v;
        if (k == 0) v = (float)pp * invL;
        else { const int band = k <= 16 ? k : k - 16; const int ph = (pp * band) & (L - 1); const float rev = (float)ph * invL; v = k <= 16 ? __builtin_amdgcn_cosf(rev) : __builtin_amdgcn_sinf(rev); }
        z[e] = v;
    }
    __syncthreads();
    const float* w1 = inp(27) + l * 33 * 64; const float* b1 = inp(28) + l * 64; const float* w2 = inp(29) + l * 4096; const float* b2 = inp(30) + l * 64;
    const float* w3 = inp(31) + (size_t)l * 64 * 2048; const float* b3 = inp(32) + l * 2048; const float* sw = inp(33) + l * 64; const float* dec = inp(34) + l * 2048;
    for (int o = t; o < 1024; o += 512) { const int ps = o >> 6, j = o & 63; float s = b1[j];
#pragma unroll 11
        for (int k = 0; k < 33; ++k) s += z[ps * 33 + k] * w1[k * 64 + j]; h1[o] = sinr(sw[j] * s); }
    __syncthreads();
    for (int o = t; o < 1024; o += 512) { const int ps = o >> 6, j = o & 63; float s = b2[j];
#pragma unroll 16
        for (int k = 0; k < 64; ++k) s += h1[ps * 64 + k] * w2[k * 64 + j]; h2[o] = sinr(sw[j] * s); }
    __syncthreads();
    float acc[4][16];
#pragma unroll
    for (int q = 0; q < 4; ++q) { const float bb = b3[t + 512 * q];
#pragma unroll
        for (int ps = 0; ps < 16; ++ps) acc[q][ps] = bb; }
#pragma unroll 4
    for (int k = 0; k < 64; ++k) { float w[4];
#pragma unroll
        for (int q = 0; q < 4; ++q) w[q] = w3[k * 2048 + t + 512 * q];
#pragma unroll
        for (int ps = 0; ps < 16; ++ps) { const float hv = h2[ps * 64 + k];
#pragma unroll
            for (int q = 0; q < 4; ++q) acc[q][ps] += hv * w[q]; } }
    float* hysum = (float*)(p.ws + WS_CTL + CTL_HYSUM);
    bf16_t* GR = (bf16_t*)(p.ws + WS_GR) + (grp ? 0 : GRP_OFF);
    const int GRLEN = grp ? 8200 : 520;
#pragma unroll
    for (int q = 0; q < 4; ++q) {
        const int o = t + 512 * q; const float ad = fabsf(dec[o]); const int order = o >> 10, dir = (o >> 9) & 1, ch = o & 511;
        float* hs = hysum + ((l * 2 + grp) * 1024 + order * 512 + ch);
        if (mode == 0) { float s = 0.f;
#pragma unroll
            for (int ps = 0; ps < 16; ++ps) { const float tt = (float)(pos0 + ps) * invL; s += fabsf(acc[q][ps] * __expf(-tt * ad)); }
            atomicAdd(hs, s);
        } else { const float inv = 1.0f / (*hs + 1e-6f); bf16_t* gr = GR + (size_t)(order * 512 + ch) * GRLEN;
#pragma unroll
            for (int ps = 0; ps < 16; ++ps) { const int pp = pos0 + ps; const float tt = (float)pp * invL; const float hv = acc[q][ps] * __expf(-tt * ad) * inv;
                const int x = dir ? (L - 1 + pp) : (L - 1 - pp); if (!(dir && pp == 0)) gr[x] = f2bf(hv); }
        }
    }
}
DI void filter_item(const Params& p, unsigned char* lds, int l, int tile, int mode) {
    if (tile < 256) filter_tile(p, lds, l, 1, tile * 16, mode); else filter_tile(p, lds, l, 0, (tile - 256) * 16, mode);
}

DI void wconv_tile(const float* W, bf16_t* Wt, int K, int N, int kt, int nt, unsigned char* lds) {
    float* tile = (float*)lds;
    const int t = otid(), k0 = kt * 256, n0 = nt * 64;
    __syncthreads();
    float4 v[8];
#pragma unroll
    for (int i = 0; i < 8; ++i) { const int e = t + 512 * i, row = e >> 4, c4 = (e & 15) * 4, n = n0 + c4;
        v[i] = make_float4(0.f, 0.f, 0.f, 0.f); if (n < N) v[i] = *(const float4*)(W + (size_t)(k0 + row) * N + n); }
#pragma unroll
    for (int i = 0; i < 8; ++i) { const int e = t + 512 * i, row = e >> 4, c4 = (e & 15) * 4;
        float* tp = tile + row * 65 + c4; tp[0] = v[i].x; tp[1] = v[i].y; tp[2] = v[i].z; tp[3] = v[i].w; }
    __syncthreads();
    const int n = t >> 3;
#pragma unroll
    for (int q = 0; q < 4; ++q) { const int ks = (t & 7) * 8 + 64 * q; float o[8];
#pragma unroll
        for (int j = 0; j < 8; ++j) o[j] = tile[(ks + j) * 65 + n];
        *(u32x4*)(Wt + (size_t)(n0 + n) * K + k0 + ks) = pack8(o); }
}
DI void wconv_item(const Params& p, unsigned char* lds, int l, int it) {
    if (it < 768) wconv_tile(inp(12) + (size_t)l * DM * INW, (bf16_t*)(p.ws + WS_WIN), DM, INW, it / 96, it % 96, lds);
    else if (it < 1024) { it -= 768; wconv_tile(inp(13) + (size_t)l * DM * DM, (bf16_t*)(p.ws + WS_WOUT), DM, DM, it / 32, it % 32, lds); }
    else if (it < 2048) { it -= 1024; wconv_tile(inp(36) + (size_t)l * DM * DFF, (bf16_t*)(p.ws + WS_W1), DM, DFF, it / 128, it % 128, lds); }
    else { it -= 2048; wconv_tile(inp(37) + (size_t)l * DFF * DM, (bf16_t*)(p.ws + WS_W2), DFF, DM, it / 32, it % 32, lds); }
}

DI void ph_norm(const Params& p, int l, int which) {
    const int t = otid(), wave = t >> 6, lane = t & 63;
    const float* mods = (const float*)(p.ws + WS_CTL + CTL_MODS);
    bf16_t* ubuf = (bf16_t*)(p.ws + WS_UBUF);
    const float* xin0 = inp(0); const float* xin1 = inp(1);
    const float* g = which == 2 ? inp(38) : (which ? inp(11) : inp(10)) + l * DM;
    const int stride = gridDim.x * 8;
    for (int tok0 = blockIdx.x * 8 + wave; tok0 < NTOK; tok0 += 2 * stride) {
        f32x4 v[2][8]; float ss[2] = {0.f, 0.f};
#pragma unroll
        for (int u = 0; u < 2; ++u) { const int tok = tok0 + u * stride;
            const float* xr = (which == 0 && l == 0) ? (tok < NPT ? xin0 + (size_t)tok * DM : xin1 + (size_t)(tok - NPT) * DM) : p.out + (size_t)tok * DM;
            if (tok < NTOK) {
#pragma unroll
                for (int i = 0; i < 8; ++i) v[u][i] = *(const f32x4*)(xr + (i * 64 + lane) * 4); }
            else {
#pragma unroll
                for (int i = 0; i < 8; ++i) v[u][i] = (f32x4){0.f, 0.f, 0.f, 0.f}; } }
#pragma unroll
        for (int u = 0; u < 2; ++u) {
#pragma unroll
            for (int i = 0; i < 8; ++i) ss[u] += v[u][i][0] * v[u][i][0] + v[u][i][1] * v[u][i][1] + v[u][i][2] * v[u][i][2] + v[u][i][3] * v[u][i][3];
#pragma unroll
            for (int o = 32; o >= 1; o >>= 1) ss[u] += __shfl_xor(ss[u], o); }
#pragma unroll
        for (int u = 0; u < 2; ++u) { const int tok = tok0 + u * stride; if (tok >= NTOK) continue;
            const float rstd = rsqrtf(ss[u] * (1.0f / DM) + 1e-6f);
            if (which < 2) {
                const int modrow = tok < NPT ? 0 : 1 + ((tok - NPT) >> 12);
                const float* sh = mods + (size_t)(l * 9 + modrow) * 12288 + (which ? 3 : 0) * DM; const float* sc = sh + DM;
#pragma unroll
                for (int i = 0; i < 8; ++i) { const int col = (i * 64 + lane) * 4; const f32x4 gv = *(const f32x4*)(g + col), scv = *(const f32x4*)(sc + col), shv = *(const f32x4*)(sh + col);
                    const f32x4 uu = v[u][i] * rstd * gv * (scv + 1.0f) + shv; u32x2 w; w.x = pk2(uu[0], uu[1]); w.y = pk2(uu[2], uu[3]); *(u32x2*)(ubuf + (size_t)tok * DM + col) = w; }
            } else {
                float* orow = p.out + (size_t)tok * DM;
#pragma unroll
                for (int i = 0; i < 8; ++i) { const int col = (i * 64 + lane) * 4; const f32x4 gv = *(const f32x4*)(g + col); *(f32x4*)(orow + col) = v[u][i] * rstd * gv; }
            }
        }
    }
}

DI void tr_put(bf16_t* T, int i, int seg, const float* v) {
#pragma unroll
    for (int j = 0; j < 8; ++j) T[(seg + j) * 72 + i] = f2bf(v[j]);
}
DI u32x4 tr_get(const bf16_t* T, int r, int seg) { return *(const u32x4*)(T + r * 72 + seg); }

DI void kvprep_item(const Params& p, unsigned char* lds, int l, int tile) {
    bf16_t* T = (bf16_t*)lds;
    const int t = otid(), i = t >> 3, sub = t & 7, seg = sub * 8;
    const int tok0 = tile * 64, tok = tok0 + i;
    int smp, b, pos, Lk; if (tok < NPT) { smp = 0; b = tok >> 8; pos = tok & 255; Lk = 256; } else { smp = 1; b = (tok - NPT) >> 12; pos = (tok - NPT) & 4095; Lk = 4608; }
    const int pos0 = pos - i;
    const bf16_t* pr = (const bf16_t*)(p.ws + WS_PROJ) + (size_t)tok * INW;
    bf16_t* kbuf = (bf16_t*)(p.ws + WS_KBUF) + (smp ? 0 : PK_OFF);
    bf16_t* vtbuf = (bf16_t*)(p.ws + WS_VTBUF) + (smp ? 0 : PK_OFF);
    {
        const int head = sub; float kv[64];
#pragma unroll
        for (int q = 0; q < 8; ++q) unpack8(*(const u32x4*)(pr + C_DK + head * 64 + q * 8), kv + q * 8);
        if (!smp) { float* nk = p.out + O_NK + ((size_t)(b * 2 + l) * 256 + pos) * 512 + head * 64;
#pragma unroll
            for (int q = 0; q < 16; ++q) *(f32x4*)(nk + q * 4) = (f32x4){kv[q * 4], kv[q * 4 + 1], kv[q * 4 + 2], kv[q * 4 + 3]}; }
        else { const float frow = (float)(pos >> 6), fcol = (float)(pos & 63);
            const float inv[8] = {1.0f, 0.31622776601683794f, 0.1f, 0.031622776601683794f, 0.01f, 0.0031622776601683794f, 0.001f, 0.00031622776601683794f};
#pragma unroll
            for (int j = 0; j < 16; ++j) { const float ang = (j < 8 ? frow : fcol) * inv[j & 7]; const float rev = ang * 0.15915494309189535f; const float cs = __builtin_amdgcn_cosf(rev), sn = __builtin_amdgcn_sinf(rev);
#pragma unroll
                for (int c = 0; c < 2; ++c) { const float x1 = kv[c * 32 + j], x2 = kv[c * 32 + 16 + j]; kv[c * 32 + j] = x1 * cs - x2 * sn; kv[c * 32 + 16 + j] = x1 * sn + x2 * cs; } } }
        bf16_t* kd = kbuf + ((size_t)(b * 8 + head) * Lk + pos) * 64;
#pragma unroll
        for (int q = 0; q < 8; ++q) *(u32x4*)(kd + q * 8) = pack8(kv + q * 8);
    }
    bf16_t* T1 = T + 64 * 72;
    for (int head = 0; head < 8; head += 2) {
        float v[8], v1[8]; unpack8(*(const u32x4*)(pr + C_DV + head * 64 + seg), v); unpack8(*(const u32x4*)(pr + C_DV + (head + 1) * 64 + seg), v1);
        if (!smp) { float* nv = p.out + O_NV + ((size_t)(b * 2 + l) * 256 + pos) * 512 + head * 64 + seg; *(f32x4*)nv = (f32x4){v[0], v[1], v[2], v[3]}; *(f32x4*)(nv + 4) = (f32x4){v[4], v[5], v[6], v[7]};
            *(f32x4*)(nv + 64) = (f32x4){v1[0], v1[1], v1[2], v1[3]}; *(f32x4*)(nv + 68) = (f32x4){v1[4], v1[5], v1[6], v1[7]}; }
        __syncthreads();
        tr_put(T, i, seg, v); tr_put(T1, i, seg, v1);
        __syncthreads();
        *(u32x4*)(vtbuf + ((size_t)(b * 8 + head) * 64 + i) * Lk + pos0 + seg) = tr_get(T, i, seg);
        *(u32x4*)(vtbuf + ((size_t)(b * 8 + head + 1) * 64 + i) * Lk + pos0 + seg) = tr_get(T1, i, seg);
    }
}
DI void ctxprep_item(const Params& p, unsigned char* lds, int l, int it) {
    bf16_t* T = (bf16_t*)lds;
    const int t = otid(), i = t >> 3, sub = t & 7, seg = sub * 8;
    const int b = it >> 3, pt = it & 7, pp = pt * 64 + i;
    bf16_t* kbuf = (bf16_t*)(p.ws + WS_KBUF); bf16_t* vtbuf = (bf16_t*)(p.ws + WS_VTBUF);
    { const int head = sub; const float* src = inp(2) + ((size_t)(b * 2 + l) * 512 + pp) * 512 + head * 64; bf16_t* kd = kbuf + ((size_t)(b * 8 + head) * 4608 + 4096 + pp) * 64;
#pragma unroll
      for (int q = 0; q < 8; ++q) { const f32x4 a = *(const f32x4*)(src + q * 8), c = *(const f32x4*)(src + q * 8 + 4); u32x4 w; w.x = pk2(a[0], a[1]); w.y = pk2(a[2], a[3]); w.z = pk2(c[0], c[1]); w.w = pk2(c[2], c[3]); *(u32x4*)(kd + q * 8) = w; } }
    for (int head = 0; head < 8; ++head) {
        const float* src = inp(3) + ((size_t)(b * 2 + l) * 512 + pp) * 512 + head * 64 + seg; const f32x4 a = *(const f32x4*)src, c = *(const f32x4*)(src + 4);
        float v[8] = {a[0], a[1], a[2], a[3], c[0], c[1], c[2], c[3]};
        __syncthreads();
        tr_put(T, i, seg, v);
        __syncthreads();
        *(u32x4*)(vtbuf + ((size_t)(b * 8 + head) * 64 + i) * 4608 + 4096 + pt * 64 + seg) = tr_get(T, i, seg);
    }
}
DI void conv3x8(const bf16_t* proj, int tok, int pos, int L, int col, const float* w  , int ldw, const float* bias, float* out) {
    const bf16_t* pr = proj + (size_t)tok * INW + col;
    float xm[8], x0[8], xp[8];
    unpack8(*(const u32x4*)pr, x0);
    if (pos > 0) unpack8(*(const u32x4*)(pr - INW), xm); else {
#pragma unroll
        for (int j = 0; j < 8; ++j) xm[j] = 0.f; }
    if (pos < L - 1) unpack8(*(const u32x4*)(pr + INW), xp); else {
#pragma unroll
        for (int j = 0; j < 8; ++j) xp[j] = 0.f; }
    const f32x4 w0a = *(const f32x4*)w, w0b = *(const f32x4*)(w + 4), w1a = *(const f32x4*)(w + ldw), w1b = *(const f32x4*)(w + ldw + 4), w2a = *(const f32x4*)(w + 2 * ldw), w2b = *(const f32x4*)(w + 2 * ldw + 4);
    const f32x4 ba = *(const f32x4*)bias, bb = *(const f32x4*)(bias + 4);
#pragma unroll
    for (int j = 0; j < 4; ++j) { out[j] = ba[j] + w0a[j] * xm[j] + w1a[j] * x0[j] + w2a[j] * xp[j]; out[4 + j] = bb[j] + w0b[j] * xm[4 + j] + w1b[j] * x0[4 + j] + w2b[j] * xp[4 + j]; }
}
DI void hyprep_item(const Params& p, unsigned char* lds, int l, int tile) {
    bf16_t* T = (bf16_t*)lds;
    const int t = otid(), i = t >> 3, seg = (t & 7) * 8;
    const int tok0 = tile * 64, tok = tok0 + i;
    int pos, L; if (tok < NPT) { pos = tok & 255; L = 256; } else { pos = (tok - NPT) & 4095; L = 4096; }
    const bf16_t* proj = (const bf16_t*)(p.ws + WS_PROJ);
    bf16_t* hvt = (bf16_t*)(p.ws + WS_HVT);
    const float* cw = inp(25) + (size_t)l * 3 * 1536; const float* cb = inp(26) + l * 1536;
    bf16_t* T1 = T + 64 * 72;
    for (int cgp = 0; cgp < 16; cgp += 2) {
        float v[8], v1[8]; conv3x8(proj, tok, pos, L, C_HY + cgp * 64 + seg, cw + cgp * 64 + seg, 1536, cb + cgp * 64 + seg, v);
        conv3x8(proj, tok, pos, L, C_HY + (cgp + 1) * 64 + seg, cw + (cgp + 1) * 64 + seg, 1536, cb + (cgp + 1) * 64 + seg, v1);
        __syncthreads();
        tr_put(T, i, seg, v); tr_put(T1, i, seg, v1);
        __syncthreads();
        *(u32x4*)(hvt + (size_t)(cgp * 64 + i) * NTOK + tok0 + seg) = tr_get(T, i, seg);
        *(u32x4*)(hvt + (size_t)((cgp + 1) * 64 + i) * NTOK + tok0 + seg) = tr_get(T1, i, seg);
    }
}
DI void xbcprep_item(const Params& p, unsigned char* lds, int l, int tile) {
    const int t = otid(), i = t >> 3, seg = (t & 7) * 8;
    const int tok = tile * 64 + i;
    int pos, L; if (tok < NPT) { pos = tok & 255; L = 256; } else { pos = (tok - NPT) & 4095; L = 4096; }
    const bf16_t* proj = (const bf16_t*)(p.ws + WS_PROJ);
    bf16_t* mix = (bf16_t*)(p.ws + WS_UBUF) + (size_t)tok * DM + 1536; bf16_t* bc = (bf16_t*)(p.ws + WS_BC) + (size_t)tok * 256;
    const float* cw = inp(19) + (size_t)l * 3 * 768; const float* cb = inp(20) + l * 768;
#pragma unroll 2
    for (int cgp = 0; cgp < 12; ++cgp) { float v[8]; conv3x8(proj, tok, pos, L, C_SX + cgp * 64 + seg, cw + cgp * 64 + seg, 768, cb + cgp * 64 + seg, v);
#pragma unroll
        for (int j = 0; j < 8; ++j) v[j] = siluf(v[j]);
        if (cgp < 8) *(u32x4*)(mix + cgp * 64 + seg) = pack8(v); else *(u32x4*)(bc + (cgp - 8) * 64 + seg) = pack8(v); }
}
DI void gla_item(const Params& p, unsigned char* lds, int l, int s, int head, int dir) {
    const Seq sq = seq_of(s);
    bf16_t* LB = (bf16_t*)lds;
    bf16_t* RAW = LB;
    bf16_t* QD = LB + 22528;
    bf16_t* KD = LB + 25088;
    bf16_t* K2T = LB + 27648;
    bf16_t* VT = LB + 29952;
    bf16_t* ATT = LB + 34560;
    bf16_t* ST = LB + 39168;
    float* BTOT = (float*)(lds + 88576);
    float* GW = (float*)(lds + 88704);
    float* GB = (float*)(lds + 90752);
    const int t = otid(), wave = t >> 6, lane = t & 63, li = lane & 15, lg = lane >> 4;
    const bf16_t* proj = (const bf16_t*)(p.ws + WS_PROJ);
    bf16_t* dst = dir ? (bf16_t*)(p.ws + WS_UBUF) + head * 64 : (bf16_t*)(p.ws + WS_GLAF) + head * 64;
    const int dstride = dir ? DM : 512;
    const int nc = sq.L >> 6;
    const int dt = wave >> 2, vt = wave & 3;
    int pfi[3], pfc[3], pfl[3]; bool pfv[3];
#pragma unroll
    for (int j = 0; j < 3; ++j) { const int e = t + 512 * j; pfv[j] = e < 1152; const int ee = pfv[j] ? e : 0; const int i = ee / 18, part = ee - 18 * i; pfi[j] = i;
        if (part < 4) { pfc[j] = C_GQ + head * 32 + part * 8; pfl[j] = i * 40 + part * 8; }
        else if (part < 8) { pfc[j] = C_GK + head * 32 + (part - 4) * 8; pfl[j] = 2560 + i * 40 + (part - 4) * 8; }
        else if (part < 16) { pfc[j] = C_GV + head * 64 + (part - 8) * 8; pfl[j] = 5120 + i * 72 + (part - 8) * 8; }
        else { pfc[j] = C_GR + dir * 16 + (part - 16) * 8; pfl[j] = 9728 + i * 24 + (part - 16) * 8; } }
    u32x4 pre[3];
#pragma unroll
    for (int j = 0; j < 3; ++j) { const int sp = pfi[j]; const int pos = dir ? sq.L - 1 - sp : sp; pre[j] = (u32x4){0u, 0u, 0u, 0u}; if (pfv[j]) pre[j] = *(const u32x4*)(proj + (size_t)(sq.base + pos) * INW + pfc[j]); }
    f32x4 Sacc = (f32x4){0.f, 0.f, 0.f, 0.f};
    if (sq.smp) { const float* s0 = inp(4) + ((size_t)((sq.b * 2 + l) * 2 + dir) * 8 + head) * 2048;
#pragma unroll
        for (int j = 0; j < 4; ++j) Sacc[j] = s0[(16 * dt + 4 * lg + j) * 64 + 16 * vt + li]; }
    __syncthreads();
    float gwr[4][16], gbr[4];
    { const float* gwp = inp(14) + (size_t)(l * 2 + dir) * 16 * 256 + head * 32 + 4 * wave; const float* gbp = inp(15) + (l * 2 + dir) * 256 + head * 32 + 4 * wave;
#pragma unroll
      for (int dd = 0; dd < 4; ++dd) { gbr[dd] = gbp[dd];
#pragma unroll
          for (int r = 0; r < 16; ++r) gwr[dd][r] = gwp[r * 256 + dd]; } }
    { u32x2 w; w.x = pk2(Sacc[0], Sacc[1]); w.y = pk2(Sacc[2], Sacc[3]); *(u32x2*)(ST + (16 * vt + li) * 40 + 16 * dt + 4 * lg) = w; }
    for (int c = 0; c < nc; ++c) {
        const int cur = c & 1;
        bf16_t* RQ = RAW + cur * 11264; const bf16_t* RK = RQ + 2560; const bf16_t* RV = RQ + 5120; const bf16_t* RG = RQ + 9728;
        const bf16_t* STc = ST + cur * 2560; bf16_t* STn = ST + (cur ^ 1) * 2560;
#pragma unroll
        for (int j = 0; j < 3; ++j) if (pfv[j]) *(u32x4*)(RQ + pfl[j]) = pre[j];
        __syncthreads();
        if (c + 1 < nc) {
#pragma unroll
            for (int j = 0; j < 3; ++j) { const int sp = 64 * (c + 1) + pfi[j]; const int pos = dir ? sq.L - 1 - sp : sp; if (pfv[j]) pre[j] = *(const u32x4*)(proj + (size_t)(sq.base + pos) * INW + pfc[j]); } }
        { float gr[16]; unpack8(*(const u32x4*)(RG + lane * 24), gr); unpack8(*(const u32x4*)(RG + lane * 24 + 8), gr + 8);
          const u32x2 qw = *(const u32x2*)(RQ + lane * 40 + 4 * wave), kw = *(const u32x2*)(RK + lane * 40 + 4 * wave);
          const float qv[4] = {lo16(qw.x), hi16(qw.x), lo16(qw.y), hi16(qw.y)}, kv[4] = {lo16(kw.x), hi16(kw.x), lo16(kw.y), hi16(kw.y)};
          float qd[4], kd[4];
#pragma unroll
          for (int dd = 0; dd < 4; ++dd) { const int d = 4 * wave + dd; float x = gbr[dd];
#pragma unroll
              for (int r = 0; r < 16; ++r) x += gr[r] * gwr[dd][r];
              float v = (fminf(x, 0.f) - __logf(1.0f + __expf(-fabsf(x)))) * 0.0625f;
#pragma unroll
              for (int off = 1; off < 64; off <<= 1) { const float u = __shfl_up(v, off); if (lane >= off) v += u; }
              const float bt = __shfl(v, 63);
              if (lane == 63) BTOT[d] = bt;
              qd[dd] = qv[dd] * 0.17677669529663687f * __expf(v); kd[dd] = kv[dd] * __expf(-v);
              K2T[d * 72 + lane] = f2bf(kv[dd] * __expf(bt - v)); }
          u32x2 w; w.x = pk2(qd[0], qd[1]); w.y = pk2(qd[2], qd[3]); *(u32x2*)(QD + lane * 40 + 4 * wave) = w;
          w.x = pk2(kd[0], kd[1]); w.y = pk2(kd[2], kd[3]); *(u32x2*)(KD + lane * 40 + 4 * wave) = w; }
        { const int v = lane, j0 = 8 * wave; u32x4 w;
          w.x = (unsigned)RV[(j0 + 0) * 72 + v] | ((unsigned)RV[(j0 + 1) * 72 + v] << 16); w.y = (unsigned)RV[(j0 + 2) * 72 + v] | ((unsigned)RV[(j0 + 3) * 72 + v] << 16);
          w.z = (unsigned)RV[(j0 + 4) * 72 + v] | ((unsigned)RV[(j0 + 5) * 72 + v] << 16); w.w = (unsigned)RV[(j0 + 6) * 72 + v] | ((unsigned)RV[(j0 + 7) * 72 + v] << 16);
          *(u32x4*)(VT + v * 72 + j0) = w; }
        __syncthreads();
#pragma unroll
        for (int tt = 0; tt < 2; ++tt) { const int id = wave + 8 * tt, it = id >> 2, jt = id & 3;
            f32x4 cacc = (f32x4){0.f, 0.f, 0.f, 0.f};
            if (jt <= it) cacc = mma16(ldfrag(KD, 16 * jt + li, 40, 8 * lg), ldfrag(QD, 16 * it + li, 40, 8 * lg), cacc);
            const int row = 16 * it + li; float av[4];
#pragma unroll
            for (int j = 0; j < 4; ++j) { const int col = 16 * jt + 4 * lg + j; av[j] = col <= row ? cacc[j] : 0.f; }
            u32x2 w; w.x = pk2(av[0], av[1]); w.y = pk2(av[2], av[3]); *(u32x2*)(ATT + row * 72 + 16 * jt + 4 * lg) = w; }
        __syncthreads();
#pragma unroll
        for (int tt = 0; tt < 2; ++tt) { const int id = wave + 8 * tt, v2 = id >> 2, it = id & 3;
            f32x4 o = (f32x4){0.f, 0.f, 0.f, 0.f};
#pragma unroll
            for (int ks = 0; ks < 2; ++ks) o = mma16(ldfrag(VT, 16 * v2 + li, 72, 32 * ks + 8 * lg), ldfrag(ATT, 16 * it + li, 72, 32 * ks + 8 * lg), o);
            o = mma16(ldfrag(STc, 16 * v2 + li, 40, 8 * lg), ldfrag(QD, 16 * it + li, 40, 8 * lg), o);
            const int i = 16 * it + li; const int sp = 64 * c + i; const int pos = dir ? sq.L - 1 - sp : sp; const size_t tok = (size_t)(sq.base + pos);
            u32x2 w; w.x = pk2(o[0], o[1]); w.y = pk2(o[2], o[3]); *(u32x2*)(dst + tok * dstride + 16 * v2 + 4 * lg) = w; }
#pragma unroll
        for (int j = 0; j < 4; ++j) Sacc[j] *= __expf(BTOT[16 * dt + 4 * lg + j]);
#pragma unroll
        for (int ks = 0; ks < 2; ++ks) Sacc = mma16(ldfrag(K2T, 16 * dt + li, 72, 32 * ks + 8 * lg), ldfrag(VT, 16 * vt + li, 72, 32 * ks + 8 * lg), Sacc);
        { u32x2 w; w.x = pk2(Sacc[0], Sacc[1]); w.y = pk2(Sacc[2], Sacc[3]); *(u32x2*)(STn + (16 * vt + li) * 40 + 16 * dt + 4 * lg) = w; }
    }
    if (!sq.smp) { float* ng = p.out + O_NG + ((size_t)((sq.b * 2 + l) * 2 + dir) * 8 + head) * 2048;
#pragma unroll
        for (int j = 0; j < 4; ++j) ng[(16 * dt + 4 * lg + j) * 64 + 16 * vt + li] = Sacc[j]; }
}

DI void ssd_item(const Params& p, unsigned char* lds, int l, int s, int head, int dir) {
    const Seq sq = seq_of(s);
    bf16_t* LB = (bf16_t*)lds;
    bf16_t* RAW = LB;
    bf16_t* XT = LB + 27648;
    bf16_t* BST = LB + 32256;
    bf16_t* W = LB + 36864;
    bf16_t* SB = LB + 41472;
    float* CUMW = (float*)(lds + 101376);
    float* RDT = (float*)(lds + 107520);
    const int t = otid(), wave = t >> 6, lane = t & 63, li = lane & 15, lg = lane >> 4;
    const bf16_t* proj = (const bf16_t*)(p.ws + WS_PROJ);
    const bf16_t* xsrc = (const bf16_t*)(p.ws + WS_UBUF) + 1536 + head * 64;
    const int grp = head >> 2;
    const bf16_t* bcsrc = (const bf16_t*)(p.ws + WS_BC) + grp * 64;
    bf16_t* dst = dir ? (bf16_t*)(p.ws + WS_UBUF) + 1024 + head * 64 : (bf16_t*)(p.ws + WS_SSDF) + head * 64;
    const int dstride = dir ? DM : 512;
    const int nc = sq.L >> 6;
    const float av = -__expf(inp(22)[(l * 2 + dir) * 8 + head]);
    const float dtb = inp(21)[(l * 2 + dir) * 8 + head];
    const float dco = dir ? inp(23)[l * 8 + head] : 0.f;
    float* cw = CUMW + wave * 192;
    int pfi[3], pfl[3], pfs[3]; const bf16_t* pfb[3];
#pragma unroll
    for (int j = 0; j < 3; ++j) { const int e = t + 512 * j; const int i = e / 24, part = e - 24 * i, arr = part >> 3, seg = (part & 7) * 8; pfi[j] = i; pfl[j] = arr * 4608 + i * 72 + seg;
        pfb[j] = arr == 0 ? xsrc + seg : bcsrc + (arr - 1) * 128 + seg; pfs[j] = arr == 0 ? DM : 256; }
    u32x4 pre[3]; bf16_t predt = 0;
#pragma unroll
    for (int j = 0; j < 3; ++j) { const int sp = pfi[j]; const int pos = dir ? sq.L - 1 - sp : sp; pre[j] = *(const u32x4*)(pfb[j] + (size_t)(sq.base + pos) * pfs[j]); }
    if (t < 64) { const int pos = dir ? sq.L - 1 - t : t; predt = proj[(size_t)(sq.base + pos) * INW + C_SDT + dir * 8 + head]; }
    f32x4 Sacc[2];
#pragma unroll
    for (int tt = 0; tt < 2; ++tt) { const int id = wave + 8 * tt, pt = id >> 2, nt = id & 3; Sacc[tt] = (f32x4){0.f, 0.f, 0.f, 0.f};
        if (sq.smp) { const float* s0 = inp(5) + ((size_t)((sq.b * 2 + l) * 2 + dir) * 8 + head) * 4096; Sacc[tt] = *(const f32x4*)(s0 + (16 * pt + li) * 64 + 16 * nt + 4 * lg); } }
    __syncthreads();
#pragma unroll
    for (int tt = 0; tt < 2; ++tt) { const int id = wave + 8 * tt, pt = id >> 2, nt = id & 3;
        u32x2 w; w.x = pk2(Sacc[tt][0], Sacc[tt][1]); w.y = pk2(Sacc[tt][2], Sacc[tt][3]); *(u32x2*)(SB + (16 * pt + li) * 72 + 16 * nt + 4 * lg) = w; }
    for (int c = 0; c < nc; ++c) {
        const int cur = c & 1;
        bf16_t* RX = RAW + cur * 13824; bf16_t* RB = RX + 4608; bf16_t* RC = RX + 9216;
        const bf16_t* SBc = SB + cur * 4608; bf16_t* SBn = SB + (cur ^ 1) * 4608;
#pragma unroll
        for (int j = 0; j < 3; ++j) *(u32x4*)(RX + pfl[j]) = pre[j];
        if (t < 64) RDT[cur * 64 + t] = bf2f(predt);
        __syncthreads();
        if (c + 1 < nc) {
#pragma unroll
            for (int j = 0; j < 3; ++j) { const int sp = 64 * (c + 1) + pfi[j]; const int pos = dir ? sq.L - 1 - sp : sp; pre[j] = *(const u32x4*)(pfb[j] + (size_t)(sq.base + pos) * pfs[j]); }
            if (t < 64) { const int sp = 64 * (c + 1) + t; const int pos = dir ? sq.L - 1 - sp : sp; predt = proj[(size_t)(sq.base + pos) * INW + C_SDT + dir * 8 + head]; } }
        float dec;
        { const float xr = RDT[cur * 64 + lane] + dtb; const float dtv = xr > 20.f ? xr : __logf(1.0f + __expf(xr));
          float v = dtv * av;
#pragma unroll
          for (int off = 1; off < 64; off <<= 1) { const float u = __shfl_up(v, off); if (lane >= off) v += u; }
          const float cumL = __shfl(v, 63); dec = __expf(cumL);
          cw[lane] = v; cw[64 + lane] = dtv; cw[128 + lane] = __expf(cumL - v) * dtv; }
        { const int ch = lane, j0 = 8 * wave; float xv[8], bv[8];
#pragma unroll
          for (int n = 0; n < 8; ++n) { xv[n] = bf2f(RX[(j0 + n) * 72 + ch]); bv[n] = bf2f(RB[(j0 + n) * 72 + ch]) * cw[128 + j0 + n]; }
          *(u32x4*)(XT + ch * 72 + j0) = pack8(xv); *(u32x4*)(BST + ch * 72 + j0) = pack8(bv); }
#pragma unroll
        for (int tt = 0; tt < 2; ++tt) { const int id = wave + 8 * tt, it = id >> 2, jt = id & 3;
            f32x4 cacc = (f32x4){0.f, 0.f, 0.f, 0.f};
            if (jt <= it) {
#pragma unroll
                for (int ks = 0; ks < 2; ++ks) cacc = mma16(ldfrag(RB, 16 * jt + li, 72, 32 * ks + 8 * lg), ldfrag(RC, 16 * it + li, 72, 32 * ks + 8 * lg), cacc); }
            const int row = 16 * it + li; const float ci = cw[row]; float wv[4];
#pragma unroll
            for (int j = 0; j < 4; ++j) { const int col = 16 * jt + 4 * lg + j; wv[j] = col <= row ? cacc[j] * __expf(ci - cw[col]) * cw[64 + col] : 0.f; }
            u32x2 w; w.x = pk2(wv[0], wv[1]); w.y = pk2(wv[2], wv[3]); *(u32x2*)(W + row * 72 + 16 * jt + 4 * lg) = w; }
        __syncthreads();
#pragma unroll
        for (int tt = 0; tt < 2; ++tt) { const int id = wave + 8 * tt, pt = id >> 2, it = id & 3;
            f32x4 y1 = (f32x4){0.f, 0.f, 0.f, 0.f}, y2 = (f32x4){0.f, 0.f, 0.f, 0.f};
#pragma unroll
            for (int ks = 0; ks < 2; ++ks) { y1 = mma16(ldfrag(XT, 16 * pt + li, 72, 32 * ks + 8 * lg), ldfrag(W, 16 * it + li, 72, 32 * ks + 8 * lg), y1);
                y2 = mma16(ldfrag(SBc, 16 * pt + li, 72, 32 * ks + 8 * lg), ldfrag(RC, 16 * it + li, 72, 32 * ks + 8 * lg), y2); }
            const int i = 16 * it + li; const float ei = __expf(cw[i]);
            const int sp = 64 * c + i; const int pos = dir ? sq.L - 1 - sp : sp; const size_t tok = (size_t)(sq.base + pos);
            const u32x2 xw = *(const u32x2*)(RX + i * 72 + 16 * pt + 4 * lg);
            u32x2 w; w.x = pk2(y1[0] + ei * y2[0] + dco * lo16(xw.x), y1[1] + ei * y2[1] + dco * hi16(xw.x)); w.y = pk2(y1[2] + ei * y2[2] + dco * lo16(xw.y), y1[3] + ei * y2[3] + dco * hi16(xw.y));
            *(u32x2*)(dst + tok * dstride + 16 * pt + 4 * lg) = w; }
#pragma unroll
        for (int tt = 0; tt < 2; ++tt) { const int id = wave + 8 * tt, pt = id >> 2, nt = id & 3;
#pragma unroll
            for (int j = 0; j < 4; ++j) Sacc[tt][j] *= dec;
#pragma unroll
            for (int ks = 0; ks < 2; ++ks) Sacc[tt] = mma16(ldfrag(BST, 16 * nt + li, 72, 32 * ks + 8 * lg), ldfrag(XT, 16 * pt + li, 72, 32 * ks + 8 * lg), Sacc[tt]);
            u32x2 w; w.x = pk2(Sacc[tt][0], Sacc[tt][1]); w.y = pk2(Sacc[tt][2], Sacc[tt][3]); *(u32x2*)(SBn + (16 * pt + li) * 72 + 16 * nt + 4 * lg) = w; }
    }
    if (!sq.smp) { float* ns = p.out + O_NS + ((size_t)((sq.b * 2 + l) * 2 + dir) * 8 + head) * 4096;
#pragma unroll
        for (int tt = 0; tt < 2; ++tt) { const int id = wave + 8 * tt, pt = id >> 2, nt = id & 3; *(f32x4*)(ns + (16 * pt + li) * 64 + 16 * nt + 4 * lg) = Sacc[tt]; } }
}

DI void attn_item(const Params& p, unsigned char* lds, int l, int s, int head, int qb) {
    const Seq sq = seq_of(s);
    bf16_t* KS = (bf16_t*)lds;
    bf16_t* VS = KS + 2 * 64 * 72;
    bf16_t* QF = VS + 2 * 64 * 72;
    const int t = otid(), wave = t >> 6, lane = t & 63, r = lane & 31, h = lane >> 5;
    const bf16_t* proj = (const bf16_t*)(p.ws + WS_PROJ);
    bf16_t* mix = (bf16_t*)(p.ws + WS_UBUF);
    const int Lk = sq.smp ? 4608 : 256, niter = Lk >> 6;
    const bf16_t* kb = (const bf16_t*)(p.ws + WS_KBUF) + (sq.smp ? 0 : PK_OFF) + (size_t)(sq.b * 8 + head) * Lk * 64;
    const bf16_t* vb = (const bf16_t*)(p.ws + WS_VTBUF) + (sq.smp ? 0 : PK_OFF) + (size_t)(sq.b * 8 + head) * 64 * Lk;
    const int qpos = qb * 256 + wave * 32 + r; const size_t qtok = (size_t)(sq.base + qpos);
    bf16_t* qf = QF + (size_t)(wave * 4 * 64 + lane) * 8;
    { const float qs = 0.17677669529663687f * 1.4426950408889634f;
      const float frow = (float)(qpos >> 6), fcol = (float)(qpos & 63);
      const float inv[8] = {1.0f, 0.31622776601683794f, 0.1f, 0.031622776601683794f, 0.01f, 0.0031622776601683794f, 0.001f, 0.00031622776601683794f};
      float cs[8], sn[8];
#pragma unroll
      for (int j = 0; j < 8; ++j) { const float ang = (h ? fcol : frow) * inv[j]; const float rev = ang * 0.15915494309189535f; cs[j] = sq.smp ? __builtin_amdgcn_cosf(rev) : 1.f; sn[j] = sq.smp ? __builtin_amdgcn_sinf(rev) : 0.f; }
#pragma unroll
      for (int c = 0; c < 2; ++c) { float x1[8], x2[8], o1[8], o2[8];
          unpack8(*(const u32x4*)(proj + qtok * INW + C_DQ + head * 64 + c * 32 + 8 * h), x1); unpack8(*(const u32x4*)(proj + qtok * INW + C_DQ + head * 64 + c * 32 + 16 + 8 * h), x2);
#pragma unroll
          for (int j = 0; j < 8; ++j) { o1[j] = (x1[j] * cs[j] - x2[j] * sn[j]) * qs; o2[j] = (x1[j] * sn[j] + x2[j] * cs[j]) * qs; }
          *(u32x4*)(qf + (c * 2 + 0) * 512) = pack8(o1); *(u32x4*)(qf + (c * 2 + 1) * 512) = pack8(o2); } }
    float lam;
    { const float* lp = inp(17) + l * 128; const int j = lane & 31; float s1 = lp[j] * lp[32 + j], s2 = lp[64 + j] * lp[96 + j];
#pragma unroll
      for (int o = 16; o >= 1; o >>= 1) { s1 += __shfl_xor(s1, o); s2 += __shfl_xor(s2, o); }
      const float lam_init = l == 0 ? 0.2f : 0.35550906759096934f; lam = __expf(s1) - __expf(s2) + lam_init; }
    f32x16 O[2][2];
#pragma unroll
    for (int c = 0; c < 2; ++c)
#pragma unroll
        for (int mt = 0; mt < 2; ++mt)
#pragma unroll
            for (int i = 0; i < 16; ++i) O[c][mt][i] = 0.f;
    float mrun[2] = {0.f, 0.f}, lrun[2] = {0.f, 0.f};
    f32x16 nmv[2];
#pragma unroll
    for (int c = 0; c < 2; ++c)
#pragma unroll
        for (int i = 0; i < 16; ++i) nmv[c][i] = 0.f;
    const int srow = t >> 3, sseg = (t & 7) * 8;
    u32x4 kreg = *(const u32x4*)(kb + (size_t)srow * 64 + sseg), vreg = *(const u32x4*)(vb + (size_t)srow * Lk + sseg);
    __syncthreads();
    *(u32x4*)(KS + srow * 72 + sseg) = kreg; *(u32x4*)(VS + srow * 72 + sseg) = vreg;
    if (wave >= 4) __builtin_amdgcn_s_setprio(1);
    for (int it = 0; it < niter; ++it) {
        __syncthreads();
        const bf16_t* Kc = KS + (it & 1) * 64 * 72; const bf16_t* Vc = VS + (it & 1) * 64 * 72;
        if (it + 1 < niter) { kreg = *(const u32x4*)(kb + (size_t)(64 * (it + 1) + srow) * 64 + sseg); vreg = *(const u32x4*)(vb + (size_t)srow * Lk + 64 * (it + 1) + sseg); }
#pragma unroll
        for (int c = 0; c < 2; ++c) {
#pragma unroll
            for (int kt = 0; kt < 2; ++kt) {
                f32x16 S = mma32(ldfrag(Kc, 32 * kt + r, 72, c * 32 + 8 * h), *(const bf16x8*)(qf + (c * 2) * 512), nmv[c]);
                S = mma32(ldfrag(Kc, 32 * kt + r, 72, c * 32 + 16 + 8 * h), *(const bf16x8*)(qf + (c * 2 + 1) * 512), S);
                float mx = fmaxf(S[0], S[1]);
#pragma unroll
                for (int i = 2; i < 16; i += 2) mx = fmaxf(mx, fmaxf(S[i], S[i + 1]));
                mx = fmaxf(mx, __shfl_xor(mx, 32));
                const bool need = (it == 0 && kt == 0) || mx > 8.0f;
                if (__ballot(need) != 0ull) {
                    const float d = need ? mx : 0.f; const float alpha = __builtin_amdgcn_exp2f(-d); mrun[c] += d; lrun[c] *= alpha;
                    { const float nm = -mrun[c];
#pragma unroll
                      for (int i = 0; i < 16; ++i) nmv[c][i] = nm; }
#pragma unroll
                    for (int mt = 0; mt < 2; ++mt)
#pragma unroll
                        for (int i = 0; i < 16; ++i) O[c][mt][i] *= alpha;
#pragma unroll
                    for (int i = 0; i < 16; ++i) S[i] -= d;
                }
                f32x2 rs2 = {0.f, 0.f};
#pragma unroll
                for (int i = 0; i < 16; i += 2) { const float e0 = __builtin_amdgcn_exp2f(S[i]), e1 = __builtin_amdgcn_exp2f(S[i + 1]); S[i] = e0; S[i + 1] = e1; rs2 += (f32x2){e0, e1}; }
                lrun[c] += rs2[0] + rs2[1];
#pragma unroll
                for (int s2 = 0; s2 < 2; ++s2) { u32x4 w; w.x = pk2(S[8 * s2], S[8 * s2 + 1]); w.y = pk2(S[8 * s2 + 2], S[8 * s2 + 3]); w.z = pk2(S[8 * s2 + 4], S[8 * s2 + 5]); w.w = pk2(S[8 * s2 + 6], S[8 * s2 + 7]);
                    const bf16x8 pbv = __builtin_bit_cast(bf16x8, w);
#pragma unroll
                    for (int mt = 0; mt < 2; ++mt) { const bf16_t* vp = Vc + (32 * mt + r) * 72 + 32 * kt + 16 * s2 + 4 * h;
                        const s16x4 lo = *(const s16x4*)vp, hi = *(const s16x4*)(vp + 8);
                        const bf16x8 a = __builtin_shufflevector(lo, hi, 0, 1, 2, 3, 4, 5, 6, 7);
                        O[c][mt] = mma32(a, pbv, O[c][mt]); } }
            }
        }
        if (it + 1 < niter) { bf16_t* Kn = KS + ((it + 1) & 1) * 64 * 72; bf16_t* Vn = VS + ((it + 1) & 1) * 64 * 72; *(u32x4*)(Kn + srow * 72 + sseg) = kreg; *(u32x4*)(Vn + srow * 72 + sseg) = vreg; }
    }
    __builtin_amdgcn_s_setprio(0);
    asm volatile("" ::: "memory");
    { const float l0 = lrun[0] + __shfl_xor(lrun[0], 32), l1 = lrun[1] + __shfl_xor(lrun[1], 32);
      const float i0 = 1.0f / l0, i1 = lam / l1; float ss = 0.f;
#pragma unroll
      for (int mt = 0; mt < 2; ++mt)
#pragma unroll
          for (int i = 0; i < 16; ++i) { const float v = O[0][mt][i] * i0 - O[1][mt][i] * i1; O[0][mt][i] = v; ss += v * v; }
      ss += __shfl_xor(ss, 32);
      const float lam_init = l == 0 ? 0.2f : 0.35550906759096934f;
      const float rstd = rsqrtf(ss * (1.0f / 64.0f) + 1e-6f) * (1.0f - lam_init);
      const float* gn = inp(18) + l * 64;
      bf16_t* orow = mix + qtok * DM + 512 + head * 64;
#pragma unroll
      for (int mt = 0; mt < 2; ++mt)
#pragma unroll
          for (int g4 = 0; g4 < 4; ++g4) { const int dv = 32 * mt + 8 * g4 + 4 * h; const f32x4 gv = *(const f32x4*)(gn + dv);
              u32x2 w; w.x = pk2(O[0][mt][4 * g4] * rstd * gv[0], O[0][mt][4 * g4 + 1] * rstd * gv[1]); w.y = pk2(O[0][mt][4 * g4 + 2] * rstd * gv[2], O[0][mt][4 * g4 + 3] * rstd * gv[3]);
              *(u32x2*)(orow + dv) = w; } }
    __syncthreads();
}

template <bool N0, bool N1>
DI void hy_mloop(const unsigned* gr32, const bf16_t* U, f32x16 (&acc)[2][2], int mlo, int mhi, int r, int h, int b, int L, int sh) {
#pragma unroll 1
    for (int m = mlo; m <= mhi; ++m) {
        bool valid[2]; int uoff[2];
#pragma unroll
        for (int nt = 0; nt < 2; ++nt) { const int acol = 32 * nt + r, asrc = acol - m; valid[nt] = asrc >= 0 && asrc < 64 && (asrc >> sh) == (acol >> sh); uoff[nt] = (b * 64 + (valid[nt] ? asrc : 0)) * 72 + 8 * h; }
        u32x4 bw[2][4];
#pragma unroll
        for (int ks = 0; ks < 4; ++ks) { if (N0) { bw[0][ks] = *(const u32x4*)(U + uoff[0] + 16 * ks); if (!valid[0]) bw[0][ks] = (u32x4){0u, 0u, 0u, 0u}; }
            if (N1) { bw[1][ks] = *(const u32x4*)(U + uoff[1] + 16 * ks); if (!valid[1]) bw[1][ks] = (u32x4){0u, 0u, 0u, 0u}; } }
#pragma unroll
        for (int ks = 0; ks < 4; ++ks) {
            bf16x8 af[2];
#pragma unroll
            for (int mt = 0; mt < 2; ++mt) { const int D = 64 * m + r + 32 * mt - 16 * ks - 8 * h; const int p0 = (L - 1) - D; const int wd = p0 >> 1; const unsigned sft = (unsigned)(p0 & 1) * 16u;
                const unsigned d0 = gr32[wd], d1 = gr32[wd + 1], d2 = gr32[wd + 2], d3 = gr32[wd + 3], d4 = gr32[wd + 4];
                u32x4 w; w.x = __builtin_amdgcn_alignbit(d1, d0, sft); w.y = __builtin_amdgcn_alignbit(d2, d1, sft); w.z = __builtin_amdgcn_alignbit(d3, d2, sft); w.w = __builtin_amdgcn_alignbit(d4, d3, sft);
                af[mt] = __builtin_bit_cast(bf16x8, w); }
            if (N0) { const bf16x8 bf = __builtin_bit_cast(bf16x8, bw[0][ks]); acc[0][0] = mma32(af[0], bf, acc[0][0]); acc[1][0] = mma32(af[1], bf, acc[1][0]); }
            if (N1) { const bf16x8 bf = __builtin_bit_cast(bf16x8, bw[1][ks]); acc[0][1] = mma32(af[0], bf, acc[0][1]); acc[1][1] = mma32(af[1], bf, acc[1][1]); }
        }
    }
}
DI void hy_item(const Params& p, unsigned char* lds, int l, int grp, int ch) {
    bf16_t* U = (bf16_t*)lds;
    bf16_t* GRL = U + 8 * 64 * 72;
    const int t = otid(), wave = t >> 6, lane = t & 63, r = lane & 31, h = lane >> 5;
    const int nb = grp ? 8 : 2, base = grp ? NPT : 0, L = grp ? 4096 : 256, sh = grp ? 6 : 2, MM = grp ? 63 : 3, GRLEN = grp ? 8200 : 520;
    bf16_t* hvt = (bf16_t*)(p.ws + WS_HVT) + (size_t)ch * NTOK + base;
    const bf16_t* hx1 = (const bf16_t*)(p.ws + WS_HVT) + (size_t)(512 + ch) * NTOK + base;
    const bf16_t* GR = (const bf16_t*)(p.ws + WS_GR) + (grp ? 0 : GRP_OFF);
    __syncthreads();
    for (int idx = t; idx < nb * 512; idx += 512) { const int b = idx >> 9, rem = idx & 511, a = rem >> 3, seg = (rem & 7) * 8;
        *(u32x4*)(U + (b * 64 + a) * 72 + seg) = *(const u32x4*)(hvt + b * 4096 + a * 64 + seg); }
    for (int o = 0; o < 2; ++o) { const bf16_t* src = GR + (size_t)(o * 512 + ch) * GRLEN;
        for (int idx = t; idx < GRLEN / 8; idx += 512) *(u32x4*)(GRL + o * 8256 + idx * 8) = *(const u32x4*)(src + idx * 8); }
    __syncthreads();
    if (wave < nb) {
        const int b = wave;
        for (int order = 0; order < 2; ++order) {
            const unsigned* gr32 = (const unsigned*)(GRL + order * 8256);
            const float skip = inp(35)[(l * 2 + order) * 512 + ch];
            f32x16 acc[2][2];
#pragma unroll
            for (int mt = 0; mt < 2; ++mt)
#pragma unroll
                for (int nt = 0; nt < 2; ++nt)
#pragma unroll
                    for (int i = 0; i < 16; ++i) acc[mt][nt][i] = 0.f;
            hy_mloop<true, false>(gr32, U, acc, -MM, (-32 < MM ? -32 : MM), r, h, b, L, sh);
            hy_mloop<true, true>(gr32, U, acc, (-MM > -31 ? -MM : -31), (MM < 31 ? MM : 31), r, h, b, L, sh);
            hy_mloop<false, true>(gr32, U, acc, 32, MM, r, h, b, L, sh);
            asm volatile("" ::: "memory");
#pragma unroll
            for (int mt = 0; mt < 2; ++mt)
#pragma unroll
                for (int nt = 0; nt < 2; ++nt)
#pragma unroll
                    for (int g4 = 0; g4 < 4; ++g4) { const int pi = 32 * mt + 8 * g4 + 4 * h, a = 32 * nt + r; bf16_t* up = U + (b * 64 + a) * 72 + pi; const size_t gofs = (size_t)b * 4096 + a * 64 + pi;
                        const u32x2 uw = *(const u32x2*)up; float y[4];
                        y[0] = acc[mt][nt][4 * g4] + skip * lo16(uw.x); y[1] = acc[mt][nt][4 * g4 + 1] + skip * hi16(uw.x); y[2] = acc[mt][nt][4 * g4 + 2] + skip * lo16(uw.y); y[3] = acc[mt][nt][4 * g4 + 3] + skip * hi16(uw.y);
                        if (order == 0) { const u32x2 xw = *(const u32x2*)(hx1 + gofs); y[0] *= lo16(xw.x); y[1] *= hi16(xw.x); y[2] *= lo16(xw.y); y[3] *= hi16(xw.y);
                            u32x2 w; w.x = pk2(y[0], y[1]); w.y = pk2(y[2], y[3]); *(u32x2*)up = w; }
                        else { u32x2 w; w.x = pk2(y[0], y[1]); w.y = pk2(y[2], y[3]); *(u32x2*)(hvt + gofs) = w; } }
        }
    }
}

DI void m3_item(const Params& p, unsigned char* lds, int l, int tile, const int half) {
    bf16_t* T = (bf16_t*)lds;
    const int t = otid(), i = t >> 3, seg = (t & 7) * 8;
    const int tok0 = tile * 64, tok = tok0 + i;
    int pos, L; if (tok < NPT) { pos = tok & 255; L = 256; } else { pos = (tok - NPT) & 4095; L = 4096; }
    const bf16_t* proj = (const bf16_t*)(p.ws + WS_PROJ);
    bf16_t* mix = (bf16_t*)(p.ws + WS_UBUF);
    const bf16_t* ot = (const bf16_t*)(p.ws + WS_HVT);
    if (half == 0) {
    {
        const bf16_t* glaf = (const bf16_t*)(p.ws + WS_GLAF) + (size_t)tok * 512; bf16_t* row = mix + (size_t)tok * DM; const bf16_t* pr = proj + (size_t)tok * INW;
        const float* gn = inp(16) + l * 64 + seg;
        float gnv[8];
#pragma unroll
        for (int j = 0; j < 8; ++j) gnv[j] = gn[j];
#pragma unroll 2
        for (int q = 0; q < 8; ++q) { float a[8], b[8], gg[8]; unpack8(*(const u32x4*)(glaf + q * 64 + seg), a); unpack8(*(const u32x4*)(row + q * 64 + seg), b); unpack8(*(const u32x4*)(pr + C_GG + q * 64 + seg), gg);
            float ss = 0.f;
#pragma unroll
            for (int j = 0; j < 8; ++j) { a[j] += b[j]; ss += a[j] * a[j]; }
            ss += __shfl_xor(ss, 1); ss += __shfl_xor(ss, 2); ss += __shfl_xor(ss, 4);
            const float rstd = rsqrtf(ss * (1.0f / 64.0f) + 1e-6f);
#pragma unroll
            for (int j = 0; j < 8; ++j) a[j] = a[j] * rstd * gnv[j] * siluf(gg[j]);
            *(u32x4*)(row + q * 64 + seg) = pack8(a); }
    }
    {
        const bf16_t* ssdf = (const bf16_t*)(p.ws + WS_SSDF) + (size_t)tok * 512; bf16_t* row = mix + (size_t)tok * DM + 1024; const bf16_t* pr = proj + (size_t)tok * INW;
        float ss = 0.f;
#pragma unroll 2
        for (int q = 0; q < 8; ++q) { float a[8], b[8], zz[8]; unpack8(*(const u32x4*)(ssdf + q * 64 + seg), a); unpack8(*(const u32x4*)(row + q * 64 + seg), b); unpack8(*(const u32x4*)(pr + C_SZ + q * 64 + seg), zz);
#pragma unroll
            for (int j = 0; j < 8; ++j) { const float y = (a[j] + b[j]) * siluf(zz[j]); a[j] = y; ss += y * y; }
            *(u32x4*)(row + q * 64 + seg) = pack8(a); }
        ss += __shfl_xor(ss, 1); ss += __shfl_xor(ss, 2); ss += __shfl_xor(ss, 4);
        const float rstd = rsqrtf(ss * (1.0f / 512.0f) + 1e-6f); const float* g = inp(24) + l * 512;
#pragma unroll 4
        for (int q = 0; q < 8; ++q) { float a[8]; unpack8(*(const u32x4*)(row + q * 64 + seg), a);
#pragma unroll
            for (int j = 0; j < 8; ++j) a[j] *= rstd * g[q * 64 + seg + j];
            *(u32x4*)(row + q * 64 + seg) = pack8(a); }
    }
    return; }
    const float* cw = inp(25) + (size_t)l * 3 * 1536 + 1024; const float* cb = inp(26) + l * 1536 + 1024;
    for (int cgp = 0; cgp < 8; ++cgp) {
        __syncthreads();
        *(u32x4*)(T + i * 72 + seg) = *(const u32x4*)(ot + (size_t)(cgp * 64 + i) * NTOK + tok0 + seg);
        __syncthreads();
        float x2[8]; conv3x8(proj, tok, pos, L, C_HY + 1024 + cgp * 64 + seg, cw + cgp * 64 + seg, 1536, cb + cgp * 64 + seg, x2);
#pragma unroll
        for (int j = 0; j < 8; ++j) x2[j] *= bf2f(T[(seg + j) * 72 + i]);
        *(u32x4*)(mix + (size_t)tok * DM + 1536 + cgp * 64 + seg) = pack8(x2);
    }
}

#ifndef PHM
#define PHM 0xFFFF
#endif
#define ON(k) ((PHM >> (k)) & 1)
constexpr int M2_ITEMS = 3584;
DI void m2_dispatch(const Params& p, unsigned char* lds, int l, int it) {
    if (it < 128) { if (ON(8)) ssd_item(p, lds, l, 32 + (it >> 4), (it >> 1) & 7, it & 1); }
    else if (it < 256) { it -= 128; if (ON(9)) gla_item(p, lds, l, 32 + (it >> 4), (it >> 1) & 7, it & 1); }
    else if (it < 1280) { it -= 256; if (ON(10)) attn_item(p, lds, l, 32 + (it >> 7), (it >> 4) & 7, it & 15); }
    else if (it < 1792) { it -= 1280; if (ON(11)) hy_item(p, lds, l, 1, it); }
    else if (it < 2304) { it -= 1792; if (ON(8)) ssd_item(p, lds, l, it >> 4, (it >> 1) & 7, it & 1); }
    else if (it < 2816) { it -= 2304; if (ON(9)) gla_item(p, lds, l, it >> 4, (it >> 1) & 7, it & 1); }
    else if (it < 3072) { it -= 2816; if (ON(10)) attn_item(p, lds, l, it >> 3, it & 7, 0); }
    else { it -= 3072; if (ON(11)) hy_item(p, lds, l, 0, it); }
}

DI void load_params(Params& q) { kargp_t ka = (kargp_t)__builtin_amdgcn_kernarg_segment_ptr(); q.out = (float*)ka[39]; q.ws = (unsigned char*)ka[40]; }
DI void gsync(unsigned* ctr, unsigned& target) {
    asm volatile("s_waitcnt vmcnt(0)" ::: "memory");
    __syncthreads();
    if (threadIdx.x == 0) {
        target += gridDim.x;
        __builtin_amdgcn_fence(__ATOMIC_RELEASE, "agent");
        asm volatile("s_waitcnt vmcnt(0)" ::: "memory");
        __hip_atomic_fetch_add(ctr, 1u, __ATOMIC_RELAXED, __HIP_MEMORY_SCOPE_AGENT);
        while (__hip_atomic_load(ctr, __ATOMIC_RELAXED, __HIP_MEMORY_SCOPE_AGENT) < target) __builtin_amdgcn_s_sleep(1);
        __builtin_amdgcn_fence(__ATOMIC_ACQUIRE, "agent");
        asm volatile("s_waitcnt vmcnt(0)" ::: "memory");
    }
    __syncthreads();
}
#define PHASE_BEGIN int G = gridDim.x, bx = blockIdx.x; asm volatile("" : "+s"(G), "+s"(bx)); Params p; load_params(p); float* mods = (float*)(p.ws + WS_CTL + CTL_MODS); (void)mods; (void)G; (void)bx;
DI void run_layer(unsigned* gctr, unsigned& gtarget, unsigned char* lds, const int l) {
    {
        PHASE_BEGIN
        if (ON(2)) ph_norm(p, l, 0);
        if (G == 256) {
            if (ON(1)) filter_item(p, lds, l, bx, 1);
            if (bx < 16) { if (ON(1)) filter_item(p, lds, l, 256 + bx, 1); if (ON(3)) { wconv_item(p, lds, l, bx); wconv_item(p, lds, l, bx + 16); } }
            else { for (int w = 32 + (bx - 16); w < 3072; w += 240) { if (ON(3)) wconv_item(p, lds, l, w); } }
        } else {
            for (int it = bx; it < 3072 + 272; it += G) { if (it < 3072) { if (ON(3)) wconv_item(p, lds, l, it); } else { if (ON(1)) filter_item(p, lds, l, it - 3072, 1); } }
        }
    }
    gsync(gctr, gtarget);
    {
        PHASE_BEGIN
        pg8::Gemm g{(const bf16_t*)(p.ws + WS_UBUF), (const bf16_t*)(p.ws + WS_WIN), NTOK, INWP, DM}; pg8::StaticOrder S; S.init(NTOK, INWP, G, bx);
        pg8::EpiBf16 E{(bf16_t*)(p.ws + WS_PROJ), INW, INW, 0};
        if (ON(4)) pg8::gemm_phase<pg8::EpiBf16>((LAS unsigned char*)lds, g, S, E);
    }
    gsync(gctr, gtarget);
    {
        PHASE_BEGIN
        for (int it = bx; it < 640 + 640 + 640 + 64; it += G) { if (it < 640) { if (ON(7)) kvprep_item(p, lds, l, it); } else if (it < 1280) { if (ON(12)) hyprep_item(p, lds, l, it - 640); } else if (it < 1920) { if (ON(12)) xbcprep_item(p, lds, l, it - 1280); } else { if (ON(13)) ctxprep_item(p, lds, l, it - 1920); } }
    }
    gsync(gctr, gtarget);
    {
        PHASE_BEGIN
        unsigned* q = (unsigned*)(p.ws + WS_CTL + CTL_Q) + l * 16;
        volatile int* slot = (volatile int*)(lds + LDS_MISC);
        int nxt = 0;
        if (threadIdx.x == 0) nxt = (int)atomicAdd(q, 1u);
        for (;;) {
            __syncthreads();
            if (threadIdx.x == 0) *slot = nxt;
            __syncthreads();
            const int it = *slot;
            if (it >= M2_ITEMS) break;
            if (threadIdx.x == 0) nxt = (int)atomicAdd(q, 1u);
            Params pi; load_params(pi);
            m2_dispatch(pi, lds, l, it);
        }
    }
    gsync(gctr, gtarget);
    {
        PHASE_BEGIN
        for (int it = bx; it < 1280; it += G) { if (ON(14)) { if (it < 640) m3_item(p, lds, l, it, 0); else m3_item(p, lds, l, it - 640, 1); } }
    }
    gsync(gctr, gtarget);
    {
        PHASE_BEGIN
        pg8::Gemm g{(const bf16_t*)(p.ws + WS_UBUF), (const bf16_t*)(p.ws + WS_WOUT), NTOK, DM, DM}; pg8::StaticOrder S; S.init(NTOK, DM, G, bx);
        pg8::EpiRes E{l == 0 ? inp(0) : p.out, l == 0 ? inp(1) : p.out + (size_t)NPT * DM, p.out, mods + (size_t)l * 9 * 12288 + 2 * DM};
        if (ON(6)) pg8::gemm_phase<pg8::EpiRes>((LAS unsigned char*)lds, g, S, E);
    }
    gsync(gctr, gtarget);
    {
        PHASE_BEGIN
        if (ON(2)) ph_norm(p, l, 1);
    }
    gsync(gctr, gtarget);
    {
        PHASE_BEGIN
        pg8::Gemm g{(const bf16_t*)(p.ws + WS_UBUF), (const bf16_t*)(p.ws + WS_W1), NTOK, DFF, DM}; pg8::StaticOrder S; S.init(NTOK, DFF, G, bx);
        pg8::EpiBf16 E{(bf16_t*)(p.ws + WS_PROJ), DFF, DFF, 1};
        if (ON(4)) pg8::gemm_phase<pg8::EpiBf16>((LAS unsigned char*)lds, g, S, E);
    }
    gsync(gctr, gtarget);
    {
        PHASE_BEGIN
        pg8::Gemm g{(const bf16_t*)(p.ws + WS_PROJ), (const bf16_t*)(p.ws + WS_W2), NTOK, DM, DFF}; pg8::StaticOrder S; S.init(NTOK, DM, G, bx);
        pg8::EpiRes E{p.out, p.out + (size_t)NPT * DM, p.out, mods + (size_t)l * 9 * 12288 + 5 * DM};
        if (ON(6)) pg8::gemm_phase<pg8::EpiRes>((LAS unsigned char*)lds, g, S, E);
    }
    gsync(gctr, gtarget);
}
__global__ void __launch_bounds__(512, 2) mega(KArgs p_unused) {
    extern __shared__ __attribute__((aligned(16))) unsigned char lds[];
    cg::grid_group grid = cg::this_grid();
    {
        PHASE_BEGIN
        for (int it = bx; it < 192 + 544; it += G) { if (it < 192) { if (ON(0)) ada_item(p, lds, it); } else { const int f = it - 192; if (ON(1)) filter_item(p, lds, f / 272, f % 272, 0); } }
    }
    grid.sync();
    unsigned gtarget = 0; unsigned* gctr;
    { Params pq; load_params(pq); gctr = (unsigned*)(pq.ws + WS_CTL + CTL_Q) + 32; }
    run_layer(gctr, gtarget, lds, 0);
    run_layer(gctr, gtarget, lds, 1);
    {
        PHASE_BEGIN
        if (ON(2)) ph_norm(p, 0, 2);
    }
}

extern "C" void kernel_launch(void* const* d_in, const int* in_sizes, int n_in, void* d_out, int out_size, void* d_ws, size_t ws_size, hipStream_t stream) {
    static int grid = 0;
    if (grid == 0) {
        if (n_in != 39 || ws_size < WS_END) { fprintf(stderr, "kernel_launch: unexpected n_in %d or ws_size %zu (need %zu)\n", n_in, ws_size, (size_t)WS_END); grid = -1; return; }
        if (hipFuncSetAttribute((const void*)mega, hipFuncAttributeMaxDynamicSharedMemorySize, LDS_BYTES) != hipSuccess) { fprintf(stderr, "kernel_launch: hipFuncSetAttribute failed\n"); grid = -1; return; }
        int dev = 0, cus = 0, per_cu = 0;
        hipGetDevice(&dev); hipDeviceGetAttribute(&cus, hipDeviceAttributeMultiprocessorCount, dev);
        hipOccupancyMaxActiveBlocksPerMultiprocessor(&per_cu, (const void*)mega, 512, LDS_BYTES);
        if (per_cu < 1) { fprintf(stderr, "kernel_launch: occupancy query says %d blocks/CU\n", per_cu); per_cu = 1; }
        grid = cus * 1;
        (void)hipGetLastError();
    }
    if (grid < 0) return;
    hipMemsetAsync((char*)d_ws + WS_CTL, 0, CTL_BYTES, stream);
    KArgs p{};
    for (int i = 0; i < 39; ++i) p.in[i] = (const float*)d_in[i];
    p.out = (float*)d_out; p.ws = (unsigned char*)d_ws; p.ph_lo = 0; p.ph_hi = NPHASE;
    void* args[] = {&p};
    hipError_t e = hipLaunchCooperativeKernel((const void*)mega, dim3(grid), dim3(512), args, LDS_BYTES, stream);
    if (e != hipSuccess) fprintf(stderr, "cooperative launch failed: %s (grid %d)\n", hipGetErrorString(e), grid);
}
```
